# Optimizing an MI355X kernel written in HIP

```python
import math
import jax, jax.numpy as jnp
from jax import lax
import numpy as np

D_MODEL = 1024
BATCH = 1
SEQ = 16384
DEPTH = 2
DEC_BATCH = 32
DEC_SEQ = 16
PAST_LEN = 2048

CHUNK = 64
Q_BLOCK = 128
A_HEADS = 4
A_HEAD_DIM = 64
A_V_DIM = 2 * A_HEAD_DIM
A_WIDTH = A_HEADS * A_V_DIM
B_HEADS = 4
B_KEY_DIM = 64
B_VAL_DIM = 128
B_WIDTH = B_HEADS * B_VAL_DIM
GATE_RANK = 16
GATE_TAU = 16.0
D_FF = 2816
ROPE_THETA = 10000.0
NORM_EPS = 1e-6
SUBLN_EPS = 1e-5
IN_SIZES = (2 * A_HEADS * A_HEAD_DIM, 2 * A_HEADS * A_HEAD_DIM, A_WIDTH,
            B_HEADS * B_KEY_DIM, B_HEADS * B_KEY_DIM, B_WIDTH, B_WIDTH,
            GATE_RANK, D_MODEL, D_MODEL)
IN_WIDTH = sum(IN_SIZES)

kernel_name = 'hybrid_diffattn_gla_streaming_step'


def rms_norm(x, g, eps=NORM_EPS):
    xf = x.astype(jnp.float32)
    y = xf * lax.rsqrt(jnp.mean(xf * xf, axis=-1, keepdims=True) + eps)
    return (y * g.astype(jnp.float32)).astype(x.dtype)


def rope(x, pos):
    half = x.shape[-1] // 2
    inv = jnp.exp(-math.log(ROPE_THETA) * jnp.arange(half, dtype=jnp.float32) / half)
    ang = pos.astype(jnp.float32)[:, None] * inv[None, :]
    cos = jnp.cos(ang)[None, :, None, :]
    sin = jnp.sin(ang)[None, :, None, :]
    xf = x.astype(jnp.float32)
    x1, x2 = xf[..., :half], xf[..., half:]
    return jnp.concatenate([x1 * cos - x2 * sin, x2 * cos + x1 * sin], axis=-1).astype(x.dtype)


def swiglu(h, wg, wu, wd):
    return (jax.nn.silu(h @ wg) * (h @ wu)) @ wd


def in_projection(h, w_in, w_gate_up, b_gate):
    bn, t = h.shape[0], h.shape[1]
    z = h @ w_in
    offs, o = [], 0
    for s in IN_SIZES[:-1]:
        o += s
        offs.append(o)
    qa, ka, va, qb, kb, vb, rb, a_lr, ga, gb = jnp.split(z, offs, axis=-1)
    qa = qa.reshape(bn, t, 2 * A_HEADS, A_HEAD_DIM)
    ka = ka.reshape(bn, t, 2 * A_HEADS, A_HEAD_DIM)
    va = va.reshape(bn, t, A_HEADS, A_V_DIM)
    qb = qb.reshape(bn, t, B_HEADS, B_KEY_DIM) * (B_KEY_DIM ** -0.5)
    kb = kb.reshape(bn, t, B_HEADS, B_KEY_DIM)
    vb = vb.reshape(bn, t, B_HEADS, B_VAL_DIM)
    log_a = jax.nn.log_sigmoid((a_lr @ w_gate_up + b_gate).astype(jnp.float32)) / GATE_TAU
    log_a = log_a.reshape(bn, t, B_HEADS, B_KEY_DIM)
    return qa, ka, va, qb, kb, vb, rb, log_a, ga, gb


def diff_lambda(lam, lam_init):
    lf = lam.astype(jnp.float32)
    return jnp.exp(jnp.sum(lf[0] * lf[1])) - jnp.exp(jnp.sum(lf[2] * lf[3])) + lam_init


def diff_attend(q, k, v, q_pos, k_pos, lam):
    bn, nq, nk = q.shape[0], q.shape[1], k.shape[1]
    s = jnp.einsum('bqhd,bkhd->bhqk', q, k).astype(jnp.float32) * (A_HEAD_DIM ** -0.5)
    visible = (k_pos[None, :] // CHUNK) <= (q_pos[:, None] // CHUNK)
    s = jnp.where(visible[None, None], s, -1e30)
    p = jax.nn.softmax(s, axis=-1).reshape(bn, A_HEADS, 2, nq, nk)
    a = p[:, :, 0] - lam * p[:, :, 1]
    return jnp.einsum('bhqk,bkhe->bqhe', a.astype(v.dtype), v)


def gla_chunked(q, k, v, log_a, s0, L):
    bn, t, nh, dk = q.shape
    dv = v.shape[-1]
    n = t // L
    out_dtype = v.dtype
    f32 = jnp.float32
    q = q.astype(f32).reshape(bn, n, L, nh, dk)
    k = k.astype(f32).reshape(bn, n, L, nh, dk)
    v = v.astype(f32).reshape(bn, n, L, nh, dv)
    b = jnp.cumsum(log_a.astype(f32).reshape(bn, n, L, nh, dk), axis=2)
    b_last = b[:, :, -1]
    qe = q * jnp.exp(b)
    ke = k * jnp.exp(-b)
    causal = jnp.tril(jnp.ones((L, L), dtype=bool))
    att = jnp.where(causal, jnp.einsum('bnihd,bnjhd->bnhij', qe, ke), 0.0)
    o = jnp.einsum('bnhij,bnjhe->bnihe', att, v)
    kd = k * jnp.exp(b_last[:, :, None] - b)
    ds = jnp.einsum('bnjhd,bnjhe->bnhde', kd, v)

    def step(s, inp):
        dec, d = inp
        return dec[..., None] * s + d, s

    s_fin, s_prev = lax.scan(step, s0.astype(f32),
                             (jnp.swapaxes(jnp.exp(b_last), 0, 1), jnp.swapaxes(ds, 0, 1)))
    o = o + jnp.einsum('bnihd,nbhde->bnihe', qe, s_prev)
    return o.reshape(bn, t, nh, dv).astype(out_dtype), s_fin


def token_mix(h, p_mix, lam_init, kv_past, s0, pos0, L):
    w_in_l, w_gu_l, b_g_l, lam_l, subln_l, glan_l, w_oa_l, w_ob_l, w_o_l = p_mix
    bn, t = h.shape[0], h.shape[1]
    qa, ka, va, qb, kb, vb, rb, log_a, ga, gb = in_projection(h, w_in_l, w_gu_l, b_g_l)
    pos = pos0 + jnp.arange(t)
    qa = rope(qa, pos)
    ka = rope(ka, pos)
    lam = diff_lambda(lam_l, lam_init)
    if kv_past is None:
        nb = t // Q_BLOCK
        q_blocks = jnp.swapaxes(qa.reshape(bn, nb, Q_BLOCK, 2 * A_HEADS, A_HEAD_DIM), 0, 1)
        p_blocks = pos.reshape(nb, Q_BLOCK)
        o = lax.map(lambda a: diff_attend(a[0], ka, va, a[1], pos, lam), (q_blocks, p_blocks))
        o_a = jnp.swapaxes(o, 0, 1).reshape(bn, t, A_HEADS, A_V_DIM)
    else:
        ck, cv = kv_past
        past = ck.shape[1]
        k_all = jnp.concatenate([ck.astype(ka.dtype), ka], axis=1)
        v_all = jnp.concatenate([cv.astype(va.dtype), va], axis=1)
        o_a = diff_attend(qa, k_all, v_all, pos, jnp.arange(past + t), lam)
    o_b, s_new = gla_chunked(qb, kb, vb, log_a, s0, L)
    ya = (rms_norm(o_a, subln_l, SUBLN_EPS) * (1.0 - lam_init)).reshape(bn, t, A_WIDTH) @ w_oa_l
    yb = (rms_norm(o_b, glan_l, SUBLN_EPS).reshape(bn, t, B_WIDTH) * jax.nn.silu(rb)) @ w_ob_l
    m = jax.nn.sigmoid(ga) * ya + jax.nn.sigmoid(gb) * yb
    return m @ w_o_l, ka, va, s_new


def trunk_layer(x, norm_l, p_ffn, p_mix, lam_init, kv_past, s0, pos0, L):
    wg, wu, wd = p_ffn
    h = rms_norm(x, norm_l[0])
    x = x + 0.5 * rms_norm(swiglu(h, wg[0], wu[0], wd[0]), norm_l[1])
    h = rms_norm(x, norm_l[2])
    y, k_new, v_new, s_new = token_mix(h, p_mix, lam_init, kv_past, s0, pos0, L)
    x = x + rms_norm(y, norm_l[3])
    h = rms_norm(x, norm_l[4])
    x = x + 0.5 * rms_norm(swiglu(h, wg[1], wu[1], wd[1]), norm_l[5])
    return x, k_new, v_new, s_new


def setup_inputs(seed: int = 0) -> dict:
    key = jax.random.key(seed)
    ks = jax.random.split(key, 20)
    f32 = jnp.float32
    nrm = lambda k, shape, scale: jax.random.normal(k, shape, f32) * scale
    return {
        'x_prompt': nrm(ks[0], (BATCH, SEQ, D_MODEL), 1.0),
        'x_sample': nrm(ks[1], (DEC_BATCH, DEC_SEQ, D_MODEL), 1.0),
        'cache_k': nrm(ks[2], (DEPTH, DEC_BATCH, PAST_LEN, 2 * A_HEADS, A_HEAD_DIM), 1.0),
        'cache_v': nrm(ks[3], (DEPTH, DEC_BATCH, PAST_LEN, A_HEADS, A_V_DIM), 1.0),
        'state_gla': nrm(ks[4], (DEPTH, DEC_BATCH, B_HEADS, B_KEY_DIM, B_VAL_DIM), 0.5),
        'norm_g': 1.0 + nrm(ks[5], (DEPTH, 6, D_MODEL), 0.01),
        'ffn_w_gate': nrm(ks[6], (DEPTH, 2, D_MODEL, D_FF), D_MODEL ** -0.5),
        'ffn_w_up': nrm(ks[7], (DEPTH, 2, D_MODEL, D_FF), D_MODEL ** -0.5),
        'ffn_w_down': nrm(ks[8], (DEPTH, 2, D_FF, D_MODEL), D_FF ** -0.5),
        'w_in': nrm(ks[9], (DEPTH, D_MODEL, IN_WIDTH), D_MODEL ** -0.5),
        'w_gate_up': nrm(ks[10], (DEPTH, GATE_RANK, B_HEADS * B_KEY_DIM), GATE_RANK ** -0.5),
        'b_gate': nrm(ks[11], (DEPTH, B_HEADS * B_KEY_DIM), 0.01),
        'lambda_p': nrm(ks[12], (DEPTH, 4, A_HEAD_DIM), 0.1),
        'subln_g': 1.0 + nrm(ks[13], (DEPTH, A_V_DIM), 0.01),
        'gla_norm_g': 1.0 + nrm(ks[14], (DEPTH, B_VAL_DIM), 0.01),
        'w_out_a': nrm(ks[15], (DEPTH, A_WIDTH, D_MODEL), A_WIDTH ** -0.5),
        'w_out_b': nrm(ks[16], (DEPTH, B_WIDTH, D_MODEL), B_WIDTH ** -0.5),
        'w_out': nrm(ks[17], (DEPTH, D_MODEL, D_MODEL), D_MODEL ** -0.5),
    }


def reference(x_prompt, x_sample, cache_k, cache_v, state_gla, norm_g, ffn_w_gate, ffn_w_up,
              ffn_w_down, w_in, w_gate_up, b_gate, lambda_p, subln_g, gla_norm_g,
              w_out_a, w_out_b, w_out):
    xp, xs = x_prompt, x_sample
    past = cache_k.shape[2]
    kp_l, vp_l, sp_l, ks_l, vs_l, ss_l = [], [], [], [], [], []
    for l in range(DEPTH):
        lam_init = 0.8 - 0.6 * math.exp(-0.3 * l)
        p_mix = (w_in[l], w_gate_up[l], b_gate[l], lambda_p[l], subln_g[l], gla_norm_g[l],
                 w_out_a[l], w_out_b[l], w_out[l])
        p_ffn = (ffn_w_gate[l], ffn_w_up[l], ffn_w_down[l])
        s0_p = jnp.zeros((xp.shape[0], B_HEADS, B_KEY_DIM, B_VAL_DIM), jnp.float32)
        xp, kp, vp, sp = trunk_layer(xp, norm_g[l], p_ffn, p_mix, lam_init, None, s0_p, 0, CHUNK)
        xs, kn, vn, sn = trunk_layer(xs, norm_g[l], p_ffn, p_mix, lam_init,
                                     (cache_k[l], cache_v[l]), state_gla[l], past, xs.shape[1])
        kp_l.append(kp); vp_l.append(vp); sp_l.append(sp)
        ks_l.append(kn); vs_l.append(vn); ss_l.append(sn)
    k_prompt = jnp.stack(kp_l)
    v_prompt = jnp.stack(vp_l)
    s_prompt = jnp.stack(sp_l)
    k_sample = jnp.stack(ks_l)
    v_sample = jnp.stack(vs_l)
    s_sample = jnp.stack(ss_l)
    return (xp, xs, k_prompt, v_prompt, s_prompt, k_sample, v_sample, s_sample)
```

```cpp
#include <hip/hip_runtime.h>
#include <hip/hip_cooperative_groups.h>
#include <cstdio>
#include <cstdint>
#include <cmath>
namespace cg = cooperative_groups;
#define GAS __attribute__((address_space(1)))
namespace pg8 {
#define PG8_LAS __attribute__((address_space(3)))
typedef unsigned short bf16_t;
typedef short bf16x8 __attribute__((ext_vector_type(8)));
typedef float f32x4 __attribute__((ext_vector_type(4)));
typedef unsigned u32x4 __attribute__((ext_vector_type(4)));
constexpr int BM = 256, BK = 64, HALF = 128, HTB = HALF * BK * 2  , STAGE_BYTES = 8 * HTB, NXCD = 8, WGM = 8;

__host__ __device__ __forceinline__ int lds_byte(int r, int c) { const int st = (r >> 4) * 2 + (c >> 5), rr = r & 15, cc = c & 31, ob = rr * 64 + cc * 2; return st * 1024 + (ob ^ (((ob >> 9) & 1) << 5)); }
__host__ __device__ __forceinline__ void stage_rc(int b, int& R, int& C) { const int st = b / 1024, sb = b % 1024, swz = sb ^ (((sb >> 9) & 1) << 5); R = (st >> 1) * 16 + swz / 64; C = (st & 1) * 32 + (swz % 64) / 2; }
__host__ __device__ __forceinline__ int perm32(int rho) { const int n = rho >> 4, i = rho & 15; return 8 * (i >> 2) + 4 * n + (i & 3); }

struct Unit { int pm, pn; };
struct Gemm { const bf16_t* A; const bf16_t* Bt; int M, N, K; };

struct StaticOrder {
    int nM, nN, nwg, G, c;
    __host__ __device__ void init(int M, int N, int G_, int c_) { nM = M / BM; nN = N / BM; nwg = nM * nN; G = G_; c = c_; }
    __host__ __device__ bool next(int i, Unit& u) const {
        const long L = (long)i * G + c; if (L >= nwg) return false;
        int wgid = (int)L; { const int q = nwg / NXCD, r = nwg % NXCD, xcd = wgid % NXCD, off = wgid / NXCD; wgid = (xcd < r ? xcd * (q + 1) : r * (q + 1) + (xcd - r) * q) + off; }
        const int nig = WGM * nN, gid = wgid / nig, fm = gid * WGM, gsz = (nM - fm) < WGM ? (nM - fm) : WGM;
        u.pm = fm + ((wgid % nig) % gsz); u.pn = (wgid % nig) / gsz; return true;
    }
    __device__ __forceinline__ void a_ready(const Unit&) const {}
    __device__ __forceinline__ void done(const Unit&) const {}
};

__device__ __forceinline__ unsigned cvt_pk_bf16(float lo, float hi) { unsigned r; asm volatile("v_cvt_pk_bf16_f32 %0, %1, %2" : "=v"(r) : "v"(lo), "v"(hi)); return r; }
typedef float f32x2 __attribute__((ext_vector_type(2)));
__device__ __forceinline__ float fast_sigmoid(float x) { return __builtin_amdgcn_rcpf(1.0f + __builtin_amdgcn_exp2f(-1.4426950408889634f * x)); }
__device__ __forceinline__ float bf2f(bf16_t b) { return __uint_as_float(((unsigned)b) << 16); }
__device__ __forceinline__ u32x4 pack8(const f32x4& v0, const f32x4& v1) { u32x4 w; w.x = cvt_pk_bf16(v0[0], v0[1]); w.y = cvt_pk_bf16(v0[2], v0[3]); w.z = cvt_pk_bf16(v1[0], v1[1]); w.w = cvt_pk_bf16(v1[2], v1[3]); return w; }
__device__ __forceinline__ void unpack8(const u32x4& w, f32x4& v0, f32x4& v1) {
    v0[0] = __uint_as_float(w.x << 16); v0[1] = __uint_as_float(w.x & 0xffff0000u); v0[2] = __uint_as_float(w.y << 16); v0[3] = __uint_as_float(w.y & 0xffff0000u);
    v1[0] = __uint_as_float(w.z << 16); v1[1] = __uint_as_float(w.z & 0xffff0000u); v1[2] = __uint_as_float(w.w << 16); v1[3] = __uint_as_float(w.w & 0xffff0000u); }

struct EpiPlain {
    static constexpr bool PERM = true, AFTER_DRAIN = false;
    bf16_t* O; int ldc;
    __device__ __forceinline__ void operator()(const f32x4 (&acc)[2][2][4][2], const Unit& u, int wr, int wc, int fr, int fq) const {
        const int row0 = u.pm * BM + wr * 64 + fr, col0 = u.pn * BM + wc * 32 + 8 * fq;
#pragma unroll
        for (int ai = 0; ai < 2; ++ai)
#pragma unroll
            for (int m = 0; m < 4; ++m) { bf16_t* rowp = O + (size_t)(row0 + ai * HALF + m * 16) * ldc + col0;
#pragma unroll
                for (int bj = 0; bj < 2; ++bj) *(GAS u32x4*)(rowp + bj * HALF) = pack8(acc[ai][bj][m][0], acc[ai][bj][m][1]); }
    }
};
struct EpiSwiGLU {
    static constexpr bool PERM = true, AFTER_DRAIN = false;
    bf16_t* O; int ldc;
    __device__ __forceinline__ void operator()(const f32x4 (&acc)[2][2][4][2], const Unit& u, int wr, int wc, int fr, int fq) const {
        const int row0 = u.pm * BM + wr * 64 + fr, col0 = u.pn * HALF + wc * 32 + 8 * fq;
#pragma unroll
        for (int ai = 0; ai < 2; ++ai)
#pragma unroll
            for (int m = 0; m < 4; ++m) { bf16_t* rowp = O + (size_t)(row0 + ai * HALF + m * 16) * ldc + col0;
                f32x4 r0, r1;
#pragma unroll
                for (int i = 0; i < 4; ++i) { const float g0 = acc[ai][0][m][0][i], g1 = acc[ai][0][m][1][i];
                    r0[i] = g0 * fast_sigmoid(g0) * acc[ai][1][m][0][i]; r1[i] = g1 * fast_sigmoid(g1) * acc[ai][1][m][1][i]; }
                *(GAS u32x4*)rowp = pack8(r0, r1); }
    }
};
template <bool ADD> struct EpiGate {
    static constexpr bool PERM = true, AFTER_DRAIN = false;
    bf16_t* O; const bf16_t* P; int ldc; const bf16_t* G; int ldg;
    __device__ __forceinline__ void operator()(const f32x4 (&acc)[2][2][4][2], const Unit& u, int wr, int wc, int fr, int fq) const {
        const int row0 = u.pm * BM + wr * 64 + fr, col0 = u.pn * BM + wc * 32 + 8 * fq;
        u32x4 gq[2][2], pq[2][2];
#define EG_LOAD(IT, SL) do { const size_t row_ = (size_t)(row0 + ((IT) >> 2) * HALF + ((IT) & 3) * 16); \
            _Pragma("unroll") for (int bj = 0; bj < 2; ++bj) { gq[SL][bj] = *(const GAS u32x4*)(G + row_ * ldg + col0 + bj * HALF); if (ADD) pq[SL][bj] = *(const GAS u32x4*)(P + row_ * ldc + col0 + bj * HALF); } } while (0)
        EG_LOAD(0, 0);
#pragma unroll
        for (int it = 0; it < 8; ++it) { const int ai = it >> 2, m = it & 3; const size_t row = (size_t)(row0 + ai * HALF + m * 16);
            if (it + 1 < 8) { if ((it & 1) == 0) EG_LOAD(it + 1, 1); else EG_LOAD(it + 1, 0); }
#pragma unroll
            for (int bj = 0; bj < 2; ++bj) { const int col = col0 + bj * HALF;
                f32x4 g0, g1; unpack8(gq[it & 1][bj], g0, g1);
                f32x4 p0 = {0.f, 0.f, 0.f, 0.f}, p1 = {0.f, 0.f, 0.f, 0.f};
                if (ADD) unpack8(pq[it & 1][bj], p0, p1);
                f32x4 r0, r1;
#pragma unroll
                for (int i = 0; i < 4; ++i) { r0[i] = p0[i] + fast_sigmoid(g0[i]) * acc[ai][bj][m][0][i]; r1[i] = p1[i] + fast_sigmoid(g1[i]) * acc[ai][bj][m][1][i]; }
                *(GAS u32x4*)(O + row * ldc + col) = pack8(r0, r1); }
            asm volatile("" ::: "memory"); }
#undef EG_LOAD
    }
};
typedef unsigned u32x2 __attribute__((ext_vector_type(2)));
struct EpiInProj {
    static constexpr bool PERM = true, AFTER_DRAIN = false;
    bf16_t* Z; int ldz; const float* ropec; const float* ropes;
    float* kout_p; float* vout_p; float* kout_s; float* vout_s; bf16_t* KC; bf16_t* VC; float qscale;
    __device__ __forceinline__ void operator()(const f32x4 (&acc)[2][2][4][2], const Unit& u, int wr, int wc, int fr, int fq) const {
        const int pn = u.pn; const int row0 = u.pm * BM + wr * 64 + fr;
        if (pn < 4) {
            const bool isk = pn >= 2; const int sec = isk ? 512 : 0, pnl = pn & 1, dbase = 16 * (wc & 1) + 4 * fq;
            f32x4 csq[2], snq[2];
#define EI_LOAD(IT, SL) do { const int row_ = row0 + ((IT) >> 2) * HALF + ((IT) & 3) * 16; const int pos_ = (row_ >= 16384) ? 2048 + ((row_ - 16384) & 15) : row_; \
                csq[SL] = *(const GAS f32x4*)(ropec + pos_ * 32 + dbase); snq[SL] = *(const GAS f32x4*)(ropes + pos_ * 32 + dbase); } while (0)
            EI_LOAD(0, 0);
#pragma unroll
            for (int it = 0; it < 8; ++it) { const int ai = it >> 2, m = it & 3; const int row = row0 + ai * HALF + m * 16; const bool smp = row >= 16384; const int sr = row - 16384;
                    if (it + 1 < 8) { if ((it & 1) == 0) EI_LOAD(it + 1, 1); else EI_LOAD(it + 1, 0); }
                    const f32x4 cs = csq[it & 1], sn = snq[it & 1];
#pragma unroll
                    for (int bj = 0; bj < 2; ++bj) { const int head = 4 * pnl + 2 * bj + (wc >> 1);
                        const f32x4 a0 = acc[ai][bj][m][0], a1 = acc[ai][bj][m][1];
                        const f32x4 x1 = {a0[0], a0[2], a1[0], a1[2]}, x2 = {a0[1], a0[3], a1[1], a1[3]};
                        f32x4 y1 = x1 * cs - x2 * sn, y2 = x2 * cs + x1 * sn;
                        const int hc = head * 64 + dbase;
                        if (isk) {
                            float* ko = smp ? kout_s + (size_t)sr * 512 + hc : kout_p + (size_t)row * 512 + hc;
                            *(GAS f32x4*)ko = y1; *(GAS f32x4*)(ko + 32) = y2;
                        } else { y1 = y1 * qscale; y2 = y2 * qscale; }
                        u32x2 w1, w2; w1.x = cvt_pk_bf16(y1[0], y1[1]); w1.y = cvt_pk_bf16(y1[2], y1[3]); w2.x = cvt_pk_bf16(y2[0], y2[1]); w2.y = cvt_pk_bf16(y2[2], y2[3]);
                        bf16_t* zp = Z + (size_t)row * ldz + sec + hc; *(GAS u32x2*)zp = w1; *(GAS u32x2*)(zp + 32) = w2;
                        if (isk && smp) { bf16_t* kc = KC + ((size_t)(sr >> 4) * 2112 + 2048 + (sr & 15)) * 512 + hc; *(GAS u32x2*)kc = w1; *(GAS u32x2*)(kc + 32) = w2; } }
                    asm volatile("" ::: "memory"); }
#undef EI_LOAD
        } else {
            const int col0 = pn * BM + wc * 32 + 8 * fq; const float sc = (pn == 6) ? 0.125f : 1.0f; const bool isv = (pn == 4 || pn == 5);
#pragma unroll
            for (int ai = 0; ai < 2; ++ai)
#pragma unroll
                for (int m = 0; m < 4; ++m) { const int row = row0 + ai * HALF + m * 16; const bool smp = row >= 16384; const int sr = row - 16384;
#pragma unroll
                    for (int bj = 0; bj < 2; ++bj) { const int col = col0 + bj * HALF;
                        const f32x4 v0 = acc[ai][bj][m][0] * sc, v1 = acc[ai][bj][m][1] * sc; const u32x4 w = pack8(v0, v1);
                        *(GAS u32x4*)(Z + (size_t)row * ldz + col) = w;
                        if (isv) { const int vc = col - 1024; float* vo = smp ? vout_s + (size_t)sr * 512 + vc : vout_p + (size_t)row * 512 + vc;
                            *(GAS f32x4*)vo = v0; *(GAS f32x4*)(vo + 4) = v1;
                            if (smp) *(GAS u32x4*)(VC + ((size_t)(sr >> 4) * 2112 + 2048 + (sr & 15)) * 512 + vc) = w; } }
                    asm volatile("" ::: "memory"); }
        }
    }
};

struct PanelRms {
    unsigned* xs;
    unsigned* cnt;
    float eps;
    __device__ __forceinline__ void run(const f32x4 (&v)[2][2][4][2], const Unit& u, int wr, int wc, int fr, int fq, PG8_LAS unsigned char* lds, int wid, int lane) const {
        PG8_LAS float* P = (PG8_LAS float*)lds;
        PG8_LAS float* S = (PG8_LAS float*)(lds + 4096);
#pragma unroll
        for (int ai = 0; ai < 2; ++ai)
#pragma unroll
            for (int m = 0; m < 4; ++m) { float s = 0.f;
#pragma unroll
                for (int bj = 0; bj < 2; ++bj)
#pragma unroll
                    for (int n = 0; n < 2; ++n) { const f32x4 x = v[ai][bj][m][n]; s += (x[0] * x[0] + x[1] * x[1]) + (x[2] * x[2] + x[3] * x[3]); }
                s += __shfl_xor(s, 16); s += __shfl_xor(s, 32);
                if (fq == 0) P[(ai * HALF + wr * 64 + m * 16 + fr) * 4 + wc] = s; }
        asm volatile("s_waitcnt lgkmcnt(0)" ::: "memory"); __builtin_amdgcn_s_barrier(); asm volatile("" ::: "memory");
        const int row = wid * 32 + (lane & 31);
        if (lane < 32) { const float tot = (P[row * 4 + 0] + P[row * 4 + 1]) + (P[row * 4 + 2] + P[row * 4 + 3]);
            __hip_atomic_store(xs + (size_t)(u.pm * BM + row) * 4 + u.pn, __float_as_uint(tot), __ATOMIC_RELAXED, __HIP_MEMORY_SCOPE_AGENT); }
        asm volatile("s_waitcnt vmcnt(0)" ::: "memory");
        if (lane == 0) __hip_atomic_fetch_add(cnt + 64 * u.pm, 1u, __ATOMIC_RELAXED, __HIP_MEMORY_SCOPE_AGENT);
        if (wid == 0) { unsigned sp = 0u;
            while ((unsigned)__builtin_amdgcn_readfirstlane(__hip_atomic_load(cnt + 64 * u.pm, __ATOMIC_RELAXED, __HIP_MEMORY_SCOPE_AGENT)) < 32u) { __builtin_amdgcn_s_sleep(2); if (++sp > (1u << 22)) break; }
            __builtin_amdgcn_fence(__ATOMIC_ACQUIRE, "agent"); }
        asm volatile("s_waitcnt vmcnt(0) lgkmcnt(0)" ::: "memory"); __builtin_amdgcn_s_barrier(); asm volatile("" ::: "memory");
        if (lane < 32) { const unsigned* sl = xs + (size_t)(u.pm * BM + row) * 4; float t = 0.f;
#pragma unroll
            for (int k = 0; k < 4; ++k) t += __uint_as_float(__hip_atomic_load(sl + k, __ATOMIC_RELAXED, __HIP_MEMORY_SCOPE_AGENT));
            S[row] = __builtin_amdgcn_rsqf(t * (1.0f / 1024.0f) + eps); }
        asm volatile("s_waitcnt lgkmcnt(0)" ::: "memory"); __builtin_amdgcn_s_barrier(); asm volatile("" ::: "memory");
    }
};
struct EpiRmsRes {
    static constexpr bool PERM = false, AFTER_DRAIN = true;
    float* x; bf16_t* H; int ldc; const float* ga; float cy; const float* gb; PanelRms st1, st2;
    __device__ __forceinline__ void fused(f32x4 (&acc)[2][2][4][2], const Unit& u, int wr, int wc, int fr, int fq, PG8_LAS unsigned char* lds, int wid, int lane) const {
        const PG8_LAS float* S = (const PG8_LAS float*)(lds + 4096);
        const int col0 = u.pn * BM + wc * 32 + 4 * fq;
        st1.run(acc, u, wr, wc, fr, fq, lds, wid, lane);
        { f32x4 g1[2][2];
#pragma unroll
          for (int bj = 0; bj < 2; ++bj)
#pragma unroll
              for (int n = 0; n < 2; ++n) g1[bj][n] = *(const GAS f32x4*)(ga + col0 + bj * HALF + n * 16) * cy;
#pragma unroll
          for (int ai = 0; ai < 2; ++ai)
#pragma unroll
              for (int m = 0; m < 4; ++m) { const int r = ai * HALF + wr * 64 + m * 16 + fr; const float sr = S[r]; const size_t off = (size_t)(u.pm * BM + r) * ldc + col0;
#pragma unroll
                  for (int bj = 0; bj < 2; ++bj)
#pragma unroll
                      for (int n = 0; n < 2; ++n) { const f32x4 bs = *(const GAS f32x4*)(x + off + bj * HALF + n * 16); acc[ai][bj][m][n] = bs + acc[ai][bj][m][n] * g1[bj][n] * sr; }
                  asm volatile("" : "+v"(acc[ai][0][m][0]), "+v"(acc[ai][0][m][1]), "+v"(acc[ai][1][m][0]), "+v"(acc[ai][1][m][1]));
                  if (m & 1) asm volatile("" ::: "memory"); } }
        const bool two = (gb != nullptr);
        if (two) st2.run(acc, u, wr, wc, fr, fq, lds, wid, lane);
        f32x4 g2[2][2];
#pragma unroll
        for (int bj = 0; bj < 2; ++bj)
#pragma unroll
            for (int n = 0; n < 2; ++n) g2[bj][n] = two ? *(const GAS f32x4*)(gb + col0 + bj * HALF + n * 16) : (f32x4){0.f, 0.f, 0.f, 0.f};
#pragma unroll
        for (int ai = 0; ai < 2; ++ai)
#pragma unroll
            for (int m = 0; m < 4; ++m) { const int r = ai * HALF + wr * 64 + m * 16 + fr; const float sr = S[r]; const size_t off = (size_t)(u.pm * BM + r) * ldc + col0;
#pragma unroll
                for (int bj = 0; bj < 2; ++bj)
#pragma unroll
                    for (int n = 0; n < 2; ++n) { const f32x4 x1 = acc[ai][bj][m][n]; *(GAS f32x4*)(x + off + bj * HALF + n * 16) = x1;
                        if (two) { const f32x4 o = x1 * g2[bj][n] * sr; u32x2 w; w.x = cvt_pk_bf16(o[0], o[1]); w.y = cvt_pk_bf16(o[2], o[3]); *(GAS u32x2*)(H + off + bj * HALF + n * 16) = w; } }
                asm volatile("" ::: "memory"); }
    }
};
template <class Epi, class Sched, bool ALIGN_EPI = false, bool SP2 = false>
__device__ __forceinline__ void gemm_phase(PG8_LAS unsigned char* lds, const Gemm g, const Sched& S, const Epi& E) {
    int tid_ = threadIdx.x; asm volatile("" : "+v"(tid_));
    const int tid = tid_, wid = __builtin_amdgcn_readfirstlane(tid >> 6), lane = tid & 63, wr = wid >> 2, wc = wid & 3, fr = lane & 15, fq = lane >> 4;
    const int K = g.K, nt = K / BK;
    unsigned voffA[2], voffB[2];
#pragma unroll
    for (int i = 0; i < 2; ++i) { int R, C; stage_rc(tid * 16 + i * 8192, R, C); const int Rb = Epi::PERM ? ((R & ~31) + perm32(R & 31)) : R;
        voffA[i] = (unsigned)(R * K + C) * 2u; voffB[i] = (unsigned)(Rb * K + C) * 2u; }
    const size_t kstep = (size_t)(BK * 2);
    const size_t hstep = (size_t)HALF * K * 2;
    const size_t tstep = 2 * hstep;
    const unsigned ldsw = (unsigned)wid * 1024u;
    const int aoff = lds_byte(wr * 64 + fr, fq * 8), boff = lds_byte(wc * 32 + fr, fq * 8);
#define PG8_SA(b, h) (((b) * 2 + (h)) * HTB)
#define PG8_SB(b, h) ((4 + (b) * 2 + (h)) * HTB)
#define PG8_STAGE(bufoff, gbase, voff) do { _Pragma("unroll") for (int _i = 0; _i < 2; ++_i) \
        __builtin_amdgcn_global_load_lds((const unsigned*)((const char*)(gbase) + (voff)[_i]), (PG8_LAS unsigned*)(lds + (bufoff) + ldsw + _i * 8192), 16, 0, 0); } while (0)
#define PG8_LDA(dst, b, h) do { _Pragma("unroll") for (int m = 0; m < 4; ++m) _Pragma("unroll") for (int k = 0; k < 2; ++k) dst[m][k] = *(const PG8_LAS bf16x8*)(lds + PG8_SA(b, h) + aoff + m * 2048 + k * 1024); } while (0)
#define PG8_LDB(dst, b, h) do { _Pragma("unroll") for (int n = 0; n < 2; ++n) _Pragma("unroll") for (int k = 0; k < 2; ++k) dst[n][k] = *(const PG8_LAS bf16x8*)(lds + PG8_SB(b, h) + boff + n * 2048 + k * 1024); } while (0)
#define PG8_MMA(ai, bj, At, Bt) do { __builtin_amdgcn_s_setprio(1); _Pragma("unroll") for (int m = 0; m < 4; ++m) _Pragma("unroll") for (int n = 0; n < 2; ++n) _Pragma("unroll") for (int k = 0; k < 2; ++k) \
        acc[ai][bj][m][n] = __builtin_amdgcn_mfma_f32_16x16x32_bf16(Bt[n][k], At[m][k], acc[ai][bj][m][n], 0, 0, 0); __builtin_amdgcn_s_setprio(0); } while (0)
#define PG8_WAIT_V(n) asm volatile("s_waitcnt vmcnt(" #n ")" ::: "memory")
#define PG8_WAIT_L(n) asm volatile("s_waitcnt lgkmcnt(" #n ")" ::: "memory")
#define PG8_BAR __builtin_amdgcn_s_barrier()
#define PG8_SCHED __builtin_amdgcn_sched_barrier(0)
    Unit cur, nxt; int ui = 0;
    if (!S.next(0, cur)) return;
    f32x4 acc[2][2][4][2];
#pragma unroll
    for (int a = 0; a < 2; ++a)
#pragma unroll
        for (int b = 0; b < 2; ++b)
#pragma unroll
            for (int m = 0; m < 4; ++m)
#pragma unroll
                for (int n = 0; n < 2; ++n) acc[a][b][m][n] = (f32x4){0.f, 0.f, 0.f, 0.f};
    bf16x8 At[4][2], B0[2][2], B1[2][2];
    const char* cA = (const char*)g.A + (size_t)cur.pm * tstep; const char* cB = (const char*)g.Bt + (size_t)cur.pn * tstep;
    S.a_ready(cur);
    if constexpr (SP2) {
        PG8_STAGE(PG8_SB(0, 0), cB, voffB); PG8_STAGE(PG8_SB(0, 1), cB + hstep, voffB); PG8_STAGE(PG8_SA(0, 0), cA, voffA); PG8_STAGE(PG8_SA(0, 1), cA + hstep, voffA);
        if (wr == 1) PG8_BAR;
        PG8_WAIT_V(2); PG8_BAR;
        PG8_STAGE(PG8_SB(1, 0), cB + kstep, voffB); PG8_STAGE(PG8_SA(1, 0), cA + kstep, voffA); PG8_STAGE(PG8_SB(1, 1), cB + hstep + kstep, voffB);
        PG8_WAIT_V(6); PG8_BAR;
    } else {
        PG8_STAGE(PG8_SB(0, 0), cB, voffB); PG8_STAGE(PG8_SA(0, 0), cA, voffA); PG8_STAGE(PG8_SB(0, 1), cB + hstep, voffB); PG8_STAGE(PG8_SA(0, 1), cA + hstep, voffA);
        if (wr == 1) PG8_BAR;
        PG8_WAIT_V(4); PG8_BAR;
        PG8_STAGE(PG8_SB(1, 0), cB + kstep, voffB); PG8_STAGE(PG8_SA(1, 0), cA + kstep, voffA); PG8_STAGE(PG8_SB(1, 1), cB + hstep + kstep, voffB);
        PG8_WAIT_V(6); PG8_BAR;
    }
    for (;;) {
        const bool has_next = S.next(ui + 1, nxt);
        const char* nA = has_next ? (const char*)g.A + (size_t)nxt.pm * tstep : cA; const char* nB = has_next ? (const char*)g.Bt + (size_t)nxt.pn * tstep : cB;
        for (int t = 0; t < nt; t += 2) {
            const bool last = (t == nt - 2);
            const char* a1 = cA + (size_t)(t + 1) * kstep;
            const char* a2 = last ? nA : cA + (size_t)(t + 2) * kstep; const char* b2 = last ? nB : cB + (size_t)(t + 2) * kstep;
            const char* a3 = a2 + kstep; const char* b3 = b2 + kstep;
            if (last && has_next) S.a_ready(nxt);
            if constexpr (SP2) {
            PG8_LDB(B0, 0, 0); PG8_LDB(B1, 0, 1); PG8_SCHED; PG8_LDA(At, 0, 0); PG8_STAGE(PG8_SA(1, 1), a1 + hstep, voffA);
            PG8_WAIT_V(8); PG8_WAIT_L(0); PG8_BAR; PG8_MMA(0, 0, At, B0); PG8_MMA(0, 1, At, B1); PG8_BAR; PG8_SCHED;
            PG8_LDA(At, 0, 1); PG8_STAGE(PG8_SB(0, 0), b2, voffB); PG8_STAGE(PG8_SB(0, 1), b2 + hstep, voffB); PG8_STAGE(PG8_SA(0, 0), a2, voffA);
            PG8_WAIT_V(8); PG8_WAIT_L(0); PG8_BAR; PG8_MMA(1, 0, At, B0); PG8_MMA(1, 1, At, B1); PG8_BAR; PG8_SCHED;
            PG8_LDB(B0, 1, 0); PG8_LDB(B1, 1, 1); PG8_SCHED; PG8_LDA(At, 1, 0); PG8_STAGE(PG8_SA(0, 1), a2 + hstep, voffA);
            PG8_WAIT_V(8); PG8_WAIT_L(0); PG8_BAR; PG8_MMA(0, 0, At, B0); PG8_MMA(0, 1, At, B1); PG8_BAR; PG8_SCHED;
            PG8_LDA(At, 1, 1); PG8_STAGE(PG8_SB(1, 0), b3, voffB); PG8_STAGE(PG8_SB(1, 1), b3 + hstep, voffB); PG8_STAGE(PG8_SA(1, 0), a3, voffA);
            PG8_WAIT_V(8); PG8_WAIT_L(0); PG8_BAR; PG8_MMA(1, 0, At, B0); PG8_MMA(1, 1, At, B1); PG8_BAR; PG8_SCHED;
            } else {
            PG8_LDB(B0, 0, 0); PG8_SCHED; PG8_LDA(At, 0, 0); PG8_STAGE(PG8_SA(1, 1), a1 + hstep, voffA);
            PG8_WAIT_L(8); PG8_BAR; PG8_WAIT_L(0); PG8_MMA(0, 0, At, B0); PG8_BAR; PG8_SCHED;
            PG8_LDB(B1, 0, 1); PG8_STAGE(PG8_SB(0, 0), b2, voffB);
            PG8_BAR; PG8_WAIT_L(0); PG8_MMA(0, 1, At, B1); PG8_BAR;
            PG8_LDA(At, 0, 1); PG8_STAGE(PG8_SA(0, 0), a2, voffA);
            PG8_BAR; PG8_WAIT_L(0); PG8_MMA(1, 0, At, B0); PG8_BAR; PG8_SCHED;
            PG8_STAGE(PG8_SB(0, 1), b2 + hstep, voffB);
            PG8_WAIT_V(6); PG8_BAR; PG8_MMA(1, 1, At, B1); PG8_BAR;
            PG8_LDB(B0, 1, 0); PG8_SCHED; PG8_LDA(At, 1, 0); PG8_STAGE(PG8_SA(0, 1), a2 + hstep, voffA);
            PG8_WAIT_L(8); PG8_BAR; PG8_WAIT_L(0); PG8_MMA(0, 0, At, B0); PG8_BAR; PG8_SCHED;
            PG8_LDB(B1, 1, 1); PG8_STAGE(PG8_SB(1, 0), b3, voffB);
            PG8_BAR; PG8_WAIT_L(0); PG8_MMA(0, 1, At, B1); PG8_BAR;
            PG8_LDA(At, 1, 1); PG8_STAGE(PG8_SA(1, 0), a3, voffA);
            PG8_BAR; PG8_WAIT_L(0); PG8_MMA(1, 0, At, B0); PG8_BAR; PG8_SCHED;
            PG8_STAGE(PG8_SB(1, 1), b3 + hstep, voffB);
            PG8_WAIT_V(6); PG8_BAR; PG8_MMA(1, 1, At, B1); PG8_BAR;
            }
        }
        if constexpr (ALIGN_EPI) { if (wr == 0) PG8_BAR; }
        if constexpr (!Epi::AFTER_DRAIN) { E(acc, cur, wr, wc, fr, fq); S.done(cur); }
        if (!has_next) break;
#pragma unroll
        for (int a = 0; a < 2; ++a)
#pragma unroll
            for (int b = 0; b < 2; ++b)
#pragma unroll
                for (int m = 0; m < 4; ++m)
#pragma unroll
                    for (int n = 0; n < 2; ++n) acc[a][b][m][n] = (f32x4){0.f, 0.f, 0.f, 0.f};
        cur = nxt; cA = nA; cB = nB; ++ui;
        if constexpr (ALIGN_EPI) { if (wr == 1) PG8_BAR; }
    }
    PG8_WAIT_V(0);
    if constexpr (!ALIGN_EPI) { if (wr == 0) PG8_BAR; }
    PG8_BAR;
    if constexpr (Epi::AFTER_DRAIN) { E.fused(acc, cur, wr, wc, fr, fq, lds, wid, lane); S.done(cur); }
#undef PG8_SA
#undef PG8_SB
#undef PG8_STAGE
#undef PG8_LDA
#undef PG8_LDB
#undef PG8_MMA
#undef PG8_WAIT_V
#undef PG8_WAIT_L
#undef PG8_BAR
#undef PG8_SCHED
}
}
using pg8::bf16_t; using pg8::bf16x8; using pg8::f32x4; using pg8::u32x4; using pg8::u32x2; using pg8::cvt_pk_bf16; using pg8::bf2f;
#define LAS __attribute__((address_space(3)))
typedef float f32x16 __attribute__((ext_vector_type(16)));
typedef short s16x4 __attribute__((ext_vector_type(4)));

constexpr int DM = 1024, MP = 16384, MS = 512, MALL = MP + MS, DFF = 2816, NGU = 2 * DFF, ZP = 5376, PAST = 2048, KCROWS = 2112;
constexpr int QA_OFF = 0, KA_OFF = 512, VA_OFF = 1024, QB_OFF = 1536, KB_OFF = 1792, VB_OFF = 2048, RB_OFF = 2560, GA_OFF = 3072, GB_OFF = 4096, ALR_OFF = 5120;
constexpr int NCHUNK = 256;
constexpr int OP = 512;
constexpr size_t O_Y = 0, O_KP = (size_t)MALL * DM, O_VP = O_KP + 2ull * MP * 512, O_SP = O_VP + 2ull * MP * 512, O_KS = O_SP + 2ull * 4 * 64 * 128,
                 O_VS = O_KS + 2ull * MS * 512, O_SS = O_VS + 2ull * MS * 512, O_END = O_SS + 2ull * 32 * 4 * 64 * 128;
constexpr size_t al256(size_t x) { return (x + 255) & ~(size_t)255; }
constexpr size_t W_CTR = 0;
constexpr size_t W_WGU = 65536;
constexpr size_t W_WD = W_WGU + 4ull * NGU * DM * 2;
constexpr size_t W_WIN = W_WD + 4ull * DM * DFF * 2;
constexpr size_t W_WOA = W_WIN + 2ull * ZP * DM * 2;
constexpr size_t W_WOB = W_WOA + 2ull * DM * 512 * 2;
constexpr size_t W_WO = W_WOB + 2ull * DM * 512 * 2;
constexpr size_t W_H = W_WO + 2ull * DM * DM * 2;
constexpr size_t W_ACT = W_H + (size_t)MALL * DM * 2;
constexpr size_t W_Y = W_ACT + (size_t)MALL * DFF * 2;
constexpr size_t W_Z = W_Y + (size_t)MALL * DM * 2;
constexpr size_t W_OAB = W_Z + (size_t)MALL * ZP * 2;
constexpr size_t W_MIX = W_OAB + (size_t)MALL * DM * 2;
constexpr size_t W_KC = W_MIX + (size_t)MALL * DM * 2;
constexpr size_t W_VC = W_KC + 2ull * 32 * KCROWS * 512 * 2;
constexpr size_t W_DS = W_VC + 2ull * 32 * KCROWS * 512 * 2;
constexpr size_t W_DEC = W_DS + (size_t)NCHUNK * 4 * 64 * 128 * 4;
constexpr size_t W_ROPE = W_DEC + (size_t)NCHUNK * 4 * 64 * 4;
constexpr size_t W_END = W_ROPE + 2ull * MP * 32 * 4;

constexpr int LDS_MAIN = 131072, LDS_TOTAL = LDS_MAIN + 1024;

struct Params {
    const float *x_prompt, *x_sample, *cache_k, *cache_v, *state_gla, *norm_g, *w_gate, *w_up, *w_down, *w_in, *w_gate_up, *b_gate, *lambda_p, *subln_g, *gla_norm_g, *w_out_a, *w_out_b, *w_out;
    float* out; unsigned char* ws;
    float inv_freq[32];
};

__device__ __forceinline__ float wave_sum(float v) {
#pragma unroll
    for (int o = 1; o < 64; o <<= 1) v += __shfl_xor(v, o);
    return v;
}
__device__ __forceinline__ float swap32_add(float v) { auto rr = __builtin_amdgcn_permlane32_swap(__float_as_uint(v), __float_as_uint(v), false, false); return __uint_as_float(rr[0]) + __uint_as_float(rr[1]); }
__device__ __forceinline__ float swap32_max(float v) { auto rr = __builtin_amdgcn_permlane32_swap(__float_as_uint(v), __float_as_uint(v), false, false); return fmaxf(__uint_as_float(rr[0]), __uint_as_float(rr[1])); }
__device__ __forceinline__ float max3f(float a, float b, float c) { float r; asm("v_max3_f32 %0, %1, %2, %3" : "=v"(r) : "v"(a), "v"(b), "v"(c)); return r; }
__device__ __forceinline__ int crow(int r, int hi) { return (r & 3) + 8 * (r >> 2) + 4 * hi; }
__device__ __forceinline__ unsigned f2bf(float f) { unsigned u = __float_as_uint(f); return (u + 0x7fffu + ((u >> 16) & 1u)) >> 16; }

__device__ __forceinline__ const float* tr_src(const float* W0, const float* W1, int mode, int np) {
    if (mode == 0) return W0 + np;
    if (mode == 1) { const int r = np & 255, pn = np >> 8; return (r < 128 ? W0 : W1) + 128 * pn + (r & 127); }
    if (np < 1024) { const int j = np & 63; return W0 + (np & ~63) + (j >> 1) + 32 * (j & 1); }
    if (np < 3072) return W0 + np;
    if (np < 5120) return W0 + np + 16;
    if (np < 5136) return W0 + 3072 + (np - 5120);
    return nullptr;
}
__device__ __forceinline__ void transpose_item(const float* W0, const float* W1, int Nsrc, int K, int mode, bf16_t* WT, LAS float* scr, int item, int nblk, int lane) {
    const int kb = item / nblk, nb = item % nblk, k0 = 64 * kb, n0 = 32 * nb;
    if (mode == 2 && n0 < 1024) {
        const float* src = tr_src(W0, W1, mode, n0 + (lane & 31));
#pragma unroll 8
        for (int i = 0; i < 32; ++i) { const int kk = 2 * i + (lane >> 5); scr[kk * 33 + (lane & 31)] = src[(size_t)(k0 + kk) * Nsrc]; }
    } else {
        const int n4 = 4 * (lane & 7); const float* src = tr_src(W0, W1, mode, n0 + n4);
#pragma unroll
        for (int i = 0; i < 8; ++i) { const int kk = 8 * i + (lane >> 3); f32x4 v = {0.f, 0.f, 0.f, 0.f}; if (src) v = *(const GAS f32x4*)(src + (size_t)(k0 + kk) * Nsrc);
            LAS float* d = scr + kk * 33 + n4; d[0] = v[0]; d[1] = v[1]; d[2] = v[2]; d[3] = v[3]; }
    }
    asm volatile("s_waitcnt lgkmcnt(0)" ::: "memory");
    const int c = lane & 7;
#pragma unroll
    for (int j = 0; j < 4; ++j) { const int n = (lane >> 3) + 8 * j; const LAS float* s = scr + (8 * c) * 33 + n;
        u32x4 o; o.x = cvt_pk_bf16(s[0 * 33], s[1 * 33]); o.y = cvt_pk_bf16(s[2 * 33], s[3 * 33]); o.z = cvt_pk_bf16(s[4 * 33], s[5 * 33]); o.w = cvt_pk_bf16(s[6 * 33], s[7 * 33]);
        *(GAS u32x4*)(WT + (size_t)(n0 + n) * K + k0 + 8 * c) = o; }
    asm volatile("s_waitcnt lgkmcnt(0)" ::: "memory");
}

template <int MODE> __device__ __forceinline__ void gemm_small(LAS unsigned char* lds, const bf16_t* A0, const bf16_t* B0, int K0, const bf16_t* A1, const bf16_t* B1, int K1, bf16_t* O, int ldo, const bf16_t* Zs) {
    int tid_ = threadIdx.x; asm volatile("" : "+v"(tid_));
    const int tid = tid_, lane = tid & 63, wid = __builtin_amdgcn_readfirstlane(tid >> 6), r32 = lane & 31, hi = lane >> 5;
    constexpr int NP = MODE == 1 ? 2 : 1;
    LAS float* R = (LAS float*)lds;
    for (int u = blockIdx.x; u < 256; u += gridDim.x) { const int um = u >> 4, un = u & 15;
        f32x16 acc[NP][2];
#pragma unroll
        for (int p = 0; p < NP; ++p)
#pragma unroll
            for (int cb = 0; cb < 2; ++cb)
#pragma unroll
                for (int r = 0; r < 16; ++r) acc[p][cb][r] = 0.f;
#pragma unroll
        for (int p = 0; p < NP; ++p) { const bf16_t* A = p ? A1 : A0; const bf16_t* B = p ? B1 : B0; const int K = p ? K1 : K0;
            const bf16_t* ap = A + (size_t)(32 * um + r32) * K + 8 * hi; const bf16_t* bp0 = B + (size_t)(64 * un + r32) * K + 8 * hi; const bf16_t* bp1 = bp0 + (size_t)32 * K;
            const int nks = K >> 4, per = nks >> 3, kb0 = wid * per;
            for (int ks = 0; ks < per; ks += 4) { bf16x8 a[4], b0[4], b1[4];
#pragma unroll
                for (int j = 0; j < 4; ++j) { const int kk = ks + j; const int kc = kb0 + ((kk < per) ? kk : 0);
                    a[j] = *(const GAS bf16x8*)(ap + 16 * kc); b0[j] = *(const GAS bf16x8*)(bp0 + 16 * kc); b1[j] = *(const GAS bf16x8*)(bp1 + 16 * kc); }
#pragma unroll
                for (int j = 0; j < 4; ++j) if (ks + j < per) {
                    acc[p][0] = __builtin_amdgcn_mfma_f32_32x32x16_bf16(a[j], b0[j], acc[p][0], 0, 0, 0); acc[p][1] = __builtin_amdgcn_mfma_f32_32x32x16_bf16(a[j], b1[j], acc[p][1], 0, 0, 0); } } }
#pragma unroll
        for (int p = 0; p < NP; ++p)
#pragma unroll
            for (int cb = 0; cb < 2; ++cb)
#pragma unroll
                for (int r = 0; r < 16; ++r) R[(((wid * NP + p) * 2 + cb) * 16 + r) * 64 + lane] = acc[p][cb][r];
        __syncthreads();
#pragma unroll
        for (int j = 0; j < 4; ++j) { const int idx = tid + 512 * j, cb = idx >> 10, r = (idx >> 6) & 15, ln = idx & 63; float v[NP];
#pragma unroll
            for (int p = 0; p < NP; ++p) { float s = 0.f;
#pragma unroll
                for (int w = 0; w < 8; ++w) s += R[(((w * NP + p) * 2 + cb) * 16 + r) * 64 + ln];
                v[p] = s; }
            const int row = 32 * um + crow(r, ln >> 5), col = 64 * un + 32 * cb + (ln & 31); float o = v[0];
            if (MODE == 1) { const GAS bf16_t* Zsg = (const GAS bf16_t*)Zs; const float ga = bf2f(Zsg[(size_t)row * ZP + GA_OFF + col]), gb = bf2f(Zsg[(size_t)row * ZP + GB_OFF + col]); o = pg8::fast_sigmoid(ga) * v[0] + pg8::fast_sigmoid(gb) * v[NP - 1]; }
            ((GAS bf16_t*)O)[(size_t)row * ldo + col] = (bf16_t)f2bf(o); }
        __syncthreads();
    }
}

__device__ __forceinline__ void rownorm_phase(const float* xinP, const float* xinS, float* xout, const bf16_t* Y, const float* ga, float cy, const float* gb, bf16_t* H, int gw, int NGW, int lane) {
    for (int m0 = gw; m0 < MALL; m0 += 2 * NGW) {
        int mr[2]; mr[0] = m0; mr[1] = (m0 + NGW < MALL) ? m0 + NGW : m0;
        f32x4 v[2][4]; u32x2 yw[2][4];
#pragma unroll
        for (int u = 0; u < 2; ++u) { const int m = mr[u]; const float* xr = (m < MP) ? xinP + (size_t)m * DM : xinS + (size_t)(m - MP) * DM;
#pragma unroll
            for (int j = 0; j < 4; ++j) v[u][j] = *(const GAS f32x4*)(xr + 4 * lane + 256 * j);
            if (Y) {
#pragma unroll
                for (int j = 0; j < 4; ++j) yw[u][j] = *(const GAS u32x2*)(Y + (size_t)m * DM + 4 * lane + 256 * j); } }
#pragma unroll
        for (int u = 0; u < 2; ++u) { const int m = mr[u];
            if (Y) {
                f32x4 y[4]; float s = 0.f;
#pragma unroll
                for (int j = 0; j < 4; ++j) { const u32x2 w = yw[u][j];
                    y[j][0] = __uint_as_float(w.x << 16); y[j][1] = __uint_as_float(w.x & 0xffff0000u); y[j][2] = __uint_as_float(w.y << 16); y[j][3] = __uint_as_float(w.y & 0xffff0000u);
                    s += (y[j][0] * y[j][0] + y[j][1] * y[j][1]) + (y[j][2] * y[j][2] + y[j][3] * y[j][3]); }
                const float rstd = cy * __builtin_amdgcn_rsqf(wave_sum(s) * (1.f / DM) + 1e-6f);
#pragma unroll
                for (int j = 0; j < 4; ++j) { const f32x4 g = *(const GAS f32x4*)(ga + 4 * lane + 256 * j); v[u][j] = v[u][j] + y[j] * g * rstd; }
            }
#pragma unroll
            for (int j = 0; j < 4; ++j) *(GAS f32x4*)(xout + (size_t)m * DM + 4 * lane + 256 * j) = v[u][j];
            if (H) {
                float s = 0.f;
#pragma unroll
                for (int j = 0; j < 4; ++j) s += (v[u][j][0] * v[u][j][0] + v[u][j][1] * v[u][j][1]) + (v[u][j][2] * v[u][j][2] + v[u][j][3] * v[u][j][3]);
                const float rstd = __builtin_amdgcn_rsqf(wave_sum(s) * (1.f / DM) + 1e-6f);
#pragma unroll
                for (int j = 0; j < 4; ++j) { const f32x4 g = *(const GAS f32x4*)(gb + 4 * lane + 256 * j); const f32x4 o = v[u][j] * g * rstd;
                    u32x2 w; w.x = cvt_pk_bf16(o[0], o[1]); w.y = cvt_pk_bf16(o[2], o[3]); *(GAS u32x2*)(H + (size_t)m * DM + 4 * lane + 256 * j) = w; }
            }
        }
    }
}

__device__ __forceinline__ void attn_unit(LAS unsigned char* lds, const bf16_t* Qp, int q_pitch, int q_clamp, const bf16_t* Kp, const bf16_t* Vp, int kv_pitch, const float* Kf, const float* Vf, int NT, int last_valid,
                                          int sample, int q0, bf16_t* Op, int out_rows, float lam, const float* subg, float oscale) {
    int tid_ = threadIdx.x; asm volatile("" : "+v"(tid_));
    const int tid = tid_, lane = tid & 63, wid = __builtin_amdgcn_readfirstlane(tid >> 6), s = wid & 1, rg = wid >> 1, r32 = lane & 31, hi = lane >> 5;
    const int nt_w = sample ? (rg == 0 ? NT : 0) : (((q0 + 32 * rg) >> 6) + 1);
    bf16x8 qf[4];
    { int qrow = 32 * rg + r32; qrow = qrow < q_clamp ? qrow : q_clamp;
#pragma unroll
      for (int d0 = 0; d0 < 4; ++d0) qf[d0] = *(const GAS bf16x8*)(Qp + (size_t)qrow * q_pitch + 64 * s + 16 * d0 + 8 * hi); }
    const int key0 = tid >> 4, ch = tid & 15;
    const bf16_t* kg = Kp + (size_t)key0 * kv_pitch + ch * 8; const bf16_t* vg = Vp + (size_t)key0 * kv_pitch + ch * 8;
    const size_t g32 = (size_t)32 * kv_pitch, gtile = (size_t)64 * kv_pitch;
    const int kl0 = (ch >> 3) * 8192 + key0 * 128 + (((ch & 7) ^ ((key0 >> 1) & 7)) << 4), kl1 = kl0 + 32 * 128;
    const int vl0 = 16384 + 256 * key0 + 16 * (ch ^ (((key0 & 3) << 2) | ((key0 >> 2) & 3))), vl1 = vl0 + 8192;
    u32x4 ra[4], rb[4];
#define ATT_LOAD(R, T) do { const bf16_t* kgn_ = kg + (size_t)(T) * gtile; const bf16_t* vgn_ = vg + (size_t)(T) * gtile; \
        R[0] = *(const GAS u32x4*)kgn_; R[1] = *(const GAS u32x4*)(kgn_ + g32); R[2] = *(const GAS u32x4*)vgn_; R[3] = *(const GAS u32x4*)(vgn_ + g32); } while (0)
#define ATT_STORE(R, BUF) do { LAS unsigned char* nb_ = lds + (BUF) * 32768; *(LAS u32x4*)(nb_ + kl0) = R[0]; *(LAS u32x4*)(nb_ + kl1) = R[1]; *(LAS u32x4*)(nb_ + vl0) = R[2]; *(LAS u32x4*)(nb_ + vl1) = R[3]; } while (0)
    const int kfo = s * 8192 + r32 * 128;
    const int q4 = (lane & 15) >> 2, g1 = (lane >> 4) & 1, p = lane & 3, c2 = 2 * g1 + (p >> 1);
    const int vbase = 16384 + 256 * (4 * hi + q4) + 8 * (p & 1);
    int cx[2]; const int q464 = 64 * q4;
#pragma unroll
    for (int j = 0; j < 2; ++j) cx[j] = 16 * (c2 ^ (hi + 2 * j)) + 2048 * j;
    f32x16 o[4];
#pragma unroll
    for (int eb = 0; eb < 4; ++eb)
#pragma unroll
        for (int r = 0; r < 16; ++r) o[eb][r] = 0.f;
    float lrun = 0.f;
    f32x16 negm;
#pragma unroll
    for (int r = 0; r < 16; ++r) negm[r] = 0.f;
#define ATT_VRD(KS) do { _Pragma("unroll") for (int eb = 0; eb < 4; ++eb) { \
        vv[2 * eb] = __builtin_bit_cast(s16x4, __builtin_amdgcn_ds_read_tr16_b64_v4i16((LAS s16x4*)(base + vbase + 4096 * (KS) + cx[0] + ((64 * eb) ^ q464)))); \
        vv[2 * eb + 1] = __builtin_bit_cast(s16x4, __builtin_amdgcn_ds_read_tr16_b64_v4i16((LAS s16x4*)(base + vbase + 4096 * (KS) + cx[1] + ((64 * eb) ^ q464)))); } } while (0)
#define ATT_COMPUTE(t) do { \
        if (t < nt_w) { \
            const LAS unsigned char* base = lds + (t & 1) * 32768; \
            f32x16 sA, sB; \
            { const LAS unsigned char* kb_ = base + kfo; bf16x8 kfa_[4], kfb_[4]; \
              _Pragma("unroll") for (int d0 = 0; d0 < 4; ++d0) { const int co = (((2 * d0 + hi) ^ ((r32 >> 1) & 7)) << 4); kfa_[d0] = *(const LAS bf16x8*)(kb_ + co); kfb_[d0] = *(const LAS bf16x8*)(kb_ + 4096 + co); } \
              __builtin_amdgcn_sched_barrier(0); \
              sA = __builtin_amdgcn_mfma_f32_32x32x16_bf16(kfa_[0], qf[0], negm, 0, 0, 0); sB = __builtin_amdgcn_mfma_f32_32x32x16_bf16(kfb_[0], qf[0], negm, 0, 0, 0); \
              _Pragma("unroll") for (int d0 = 1; d0 < 4; ++d0) { sA = __builtin_amdgcn_mfma_f32_32x32x16_bf16(kfa_[d0], qf[d0], sA, 0, 0, 0); sB = __builtin_amdgcn_mfma_f32_32x32x16_bf16(kfb_[d0], qf[d0], sB, 0, 0, 0); } \
              __builtin_amdgcn_sched_barrier(0); } \
            if (t == NT - 1 && last_valid < 64) { \
                _Pragma("unroll") for (int r = 0; r < 16; ++r) { const int kv = crow(r, hi); if (kv >= last_valid) sA[r] = -INFINITY; if (kv + 32 >= last_valid) sB[r] = -INFINITY; } } \
            asm volatile("s_nop 15\n\ts_nop 7" : "+v"(sA), "+v"(sB));     \
            float rm; { float a_ = max3f(sA[0], sA[1], sB[0]), b_ = max3f(sA[2], sA[3], sB[1]); a_ = max3f(a_, sB[2], sB[3]); \
              _Pragma("unroll") for (int r = 4; r < 16; r += 4) { a_ = max3f(a_, sA[r], sA[r + 1]); b_ = max3f(b_, sA[r + 2], sA[r + 3]); a_ = max3f(a_, sB[r], sB[r + 1]); b_ = max3f(b_, sB[r + 2], sB[r + 3]); } \
              rm = fmaxf(a_, b_); } \
            rm = swap32_max(rm); \
            if (t == 0 || __any(rm > 8.0f)) { const float dl = (t == 0) ? rm : fmaxf(rm, 0.f); const float f = __builtin_amdgcn_exp2f(-dl); const float nm = negm[0] - dl; lrun *= f; \
                _Pragma("unroll") for (int eb = 0; eb < 4; ++eb) _Pragma("unroll") for (int r = 0; r < 16; ++r) o[eb][r] *= f; \
                _Pragma("unroll") for (int r = 0; r < 16; ++r) { sA[r] -= dl; sB[r] -= dl; negm[r] = nm; } } \
            float ls = 0.f; \
            _Pragma("unroll") for (int r = 0; r < 16; ++r) { sA[r] = __builtin_amdgcn_exp2f(sA[r]); sB[r] = __builtin_amdgcn_exp2f(sB[r]); ls += sA[r] + sB[r]; } \
            lrun += ls; \
            u32x4 pw[4]; \
            _Pragma("unroll") for (int i = 0; i < 4; ++i) { pw[0][i] = cvt_pk_bf16(sA[2 * i], sA[2 * i + 1]); pw[1][i] = cvt_pk_bf16(sA[8 + 2 * i], sA[9 + 2 * i]); pw[2][i] = cvt_pk_bf16(sB[2 * i], sB[2 * i + 1]); pw[3][i] = cvt_pk_bf16(sB[8 + 2 * i], sB[9 + 2 * i]); } \
            s16x4 vv[8]; \
            _Pragma("unroll") for (int ks = 0; ks < 4; ++ks) { const bf16x8 pf = __builtin_bit_cast(bf16x8, pw[ks]); \
                ATT_VRD(ks); \
                __builtin_amdgcn_sched_barrier(0); \
                _Pragma("unroll") for (int eb = 0; eb < 4; ++eb) { const s16x4 lo = vv[2 * eb], hh = vv[2 * eb + 1]; \
                    const bf16x8 vf = {lo[0], lo[1], lo[2], lo[3], hh[0], hh[1], hh[2], hh[3]}; \
                    o[eb] = __builtin_amdgcn_mfma_f32_32x32x16_bf16(vf, pf, o[eb], 0, 0, 0); } \
                __builtin_amdgcn_sched_barrier(0); } \
        } \
        } while (0)
#define ATT_STEP(RW, RN, T) do { const int t_ = (T); \
        if (t_ + 2 < NT) ATT_LOAD(RN, t_ + 2); \
        ATT_COMPUTE(t_); \
        if (t_ + 1 < NT) ATT_STORE(RW, (t_ + 1) & 1); \
        __syncthreads(); } while (0)
    if (!sample) {
        ATT_LOAD(ra, 0);
        if (NT > 1) ATT_LOAD(rb, 1);
        ATT_STORE(ra, 0);
        __syncthreads();
        int tt = 0;
        for (; tt + 1 < NT; tt += 2) { ATT_STEP(rb, ra, tt); ATT_STEP(ra, rb, tt + 1); }
        if (tt < NT) ATT_STEP(rb, ra, tt);
    } else {
        const float* kfp = Kf + (size_t)key0 * 512 + ch * 8; const float* vfp = Vf + (size_t)key0 * 512 + ch * 8;
#define ATT_LOADF(T) do { const float* kfn_ = kfp + (size_t)(T) * 32768; const float* vfn_ = vfp + (size_t)(T) * 32768; \
            ra[0] = *(const GAS u32x4*)kfn_; ra[1] = *(const GAS u32x4*)(kfn_ + 4); ra[2] = *(const GAS u32x4*)(kfn_ + 16384); ra[3] = *(const GAS u32x4*)(kfn_ + 16388); \
            rb[0] = *(const GAS u32x4*)vfn_; rb[1] = *(const GAS u32x4*)(vfn_ + 4); rb[2] = *(const GAS u32x4*)(vfn_ + 16384); rb[3] = *(const GAS u32x4*)(vfn_ + 16388); } while (0)
#define ATT_F4(x) __builtin_bit_cast(f32x4, x)
#define ATT_STOREF(BUF) do { LAS unsigned char* nb_ = lds + (BUF) * 32768; \
            *(LAS u32x4*)(nb_ + kl0) = pg8::pack8(ATT_F4(ra[0]), ATT_F4(ra[1])); *(LAS u32x4*)(nb_ + kl1) = pg8::pack8(ATT_F4(ra[2]), ATT_F4(ra[3])); \
            *(LAS u32x4*)(nb_ + vl0) = pg8::pack8(ATT_F4(rb[0]), ATT_F4(rb[1])); *(LAS u32x4*)(nb_ + vl1) = pg8::pack8(ATT_F4(rb[2]), ATT_F4(rb[3])); } while (0)
        ATT_LOADF(0); ATT_STOREF(0);
        __syncthreads();
        for (int ts = 0; ts < NT; ++ts) {
            if (ts + 2 < NT) ATT_LOADF(ts + 1); else if (ts + 1 < NT) ATT_LOAD(ra, ts + 1);
            ATT_COMPUTE(ts);
            if (ts + 2 < NT) ATT_STOREF((ts + 1) & 1); else if (ts + 1 < NT) ATT_STORE(ra, (ts + 1) & 1);
            __syncthreads();
        }
#undef ATT_LOADF
#undef ATT_F4
#undef ATT_STOREF
    }
#undef ATT_COMPUTE
#undef ATT_LOAD
#undef ATT_STORE
#undef ATT_VRD
#undef ATT_STEP
    const float lt = swap32_add(lrun); const float inv = __builtin_amdgcn_rcpf(lt);
    LAS float* X = (LAS float*)(lds + 65536 + rg * 16384);
    if (s == 1 && nt_w > 0) {
#pragma unroll
        for (int eb = 0; eb < 4; ++eb)
#pragma unroll
            for (int r = 0; r < 16; ++r) X[(eb * 16 + r) * 64 + lane] = o[eb][r] * inv;
    }
    __syncthreads();
    if (s == 0 && nt_w > 0) {
        float ss = 0.f;
#pragma unroll
        for (int eb = 0; eb < 4; ++eb)
#pragma unroll
            for (int r = 0; r < 16; ++r) { const float v = o[eb][r] * inv - lam * X[(eb * 16 + r) * 64 + lane]; o[eb][r] = v; ss += v * v; }
        ss = swap32_add(ss);
        const float rstd = __builtin_amdgcn_rsqf(ss * (1.f / 128.f) + 1e-5f) * oscale;
        const int row = 32 * rg + r32;
        if (row < out_rows) {
#pragma unroll
            for (int eb = 0; eb < 4; ++eb)
#pragma unroll
                for (int g4 = 0; g4 < 4; ++g4) { const int e = 32 * eb + 8 * g4 + 4 * hi; const f32x4 g = *(const GAS f32x4*)(subg + e);
                    u32x2 w; w.x = cvt_pk_bf16(o[eb][4 * g4] * rstd * g[0], o[eb][4 * g4 + 1] * rstd * g[1]); w.y = cvt_pk_bf16(o[eb][4 * g4 + 2] * rstd * g[2], o[eb][4 * g4 + 3] * rstd * g[3]);
                    *(GAS u32x2*)(Op + (size_t)row * OP + e) = w; }
        }
    }
    __syncthreads();
}

constexpr int G_LA = 0, G_ALR = 16640, G_WG = G_ALR + 4096, G_BG = G_WG + 4096, G_SEG = G_BG + 256, G_KE = G_SEG + 2048, G_KDT = G_KE + 9216, G_QE = G_KDT + 9216, G_ATT = G_QE + 9216, G_VT = G_ATT + 9216, G_ST = G_VT + 18432, G_END = G_ST + 18432;
static_assert(G_KDT >= 64 * 132 * 4, "OBUF aliases LA..KE");
static_assert(G_END <= LDS_MAIN, "gla lds");
template <int MODE> __device__ __forceinline__ void gla_unit(LAS unsigned char* lds, const bf16_t* Zr, int ntok, const float* wgu, const float* bgp, int h, float* ds_out, float* dec_out,
                                                              const float* Sprev, float* sfin, const float* glang, bf16_t* Oout) {
    int tid_ = threadIdx.x; asm volatile("" : "+v"(tid_));
    const int tid = tid_, lane = tid & 63, wid = __builtin_amdgcn_readfirstlane(tid >> 6), r32 = lane & 31, hi = lane >> 5;
    const GAS bf16_t* Zg = (const GAS bf16_t*)Zr; const GAS float* wgu_g = (const GAS float*)wgu; const GAS float* bg_g = (const GAS float*)bgp; const GAS float* Sp_g = (const GAS float*)Sprev;
    GAS float* ds_g = (GAS float*)ds_out; GAS float* dec_g = (GAS float*)dec_out; GAS float* sf_g = (GAS float*)sfin; const GAS float* gl_g = (const GAS float*)glang;
    const int pt = tid >> 3, pd8 = (tid & 7) * 8, vt0 = tid >> 4, vc8 = (tid & 15) * 8;
    u32x4 qw = {0u, 0u, 0u, 0u}, kw = qw, vw0 = qw, vw1 = qw, rw0 = qw, rw1 = qw; f32x4 sw[4];
    if (pt < ntok) { qw = *(const GAS u32x4*)(Zg + (size_t)pt * ZP + QB_OFF + 64 * h + pd8); kw = *(const GAS u32x4*)(Zg + (size_t)pt * ZP + KB_OFF + 64 * h + pd8); }
    if (vt0 < ntok) vw0 = *(const GAS u32x4*)(Zg + (size_t)vt0 * ZP + VB_OFF + 128 * h + vc8);
    if (vt0 + 32 < ntok) vw1 = *(const GAS u32x4*)(Zg + (size_t)(vt0 + 32) * ZP + VB_OFF + 128 * h + vc8);
    if (MODE != 0) {
#pragma unroll
        for (int j = 0; j < 4; ++j) { const int idx = tid + 512 * j; sw[j] = *(const GAS f32x4*)(Sp_g + (idx >> 5) * 128 + (idx & 31) * 4); }
        if (pt < ntok) { const GAS bf16_t* rbp = Zg + (size_t)pt * ZP + RB_OFF + 128 * h + 16 * (tid & 7); rw0 = *(const GAS u32x4*)rbp; rw1 = *(const GAS u32x4*)(rbp + 8); }
    }
    LAS float* LA = (LAS float*)(lds + G_LA); LAS float* ALR = (LAS float*)(lds + G_ALR); LAS float* WG = (LAS float*)(lds + G_WG); LAS float* BG = (LAS float*)(lds + G_BG); LAS float* SEG = (LAS float*)(lds + G_SEG);
    LAS bf16_t* KE = (LAS bf16_t*)(lds + G_KE); LAS bf16_t* KDT = (LAS bf16_t*)(lds + G_KDT); LAS bf16_t* QE = (LAS bf16_t*)(lds + G_QE); LAS bf16_t* ATT = (LAS bf16_t*)(lds + G_ATT);
    LAS bf16_t* VT = (LAS bf16_t*)(lds + G_VT); LAS bf16_t* ST = (LAS bf16_t*)(lds + G_ST); LAS float* OB = (LAS float*)(lds + 0);
#pragma unroll
    for (int j = 0; j < 2; ++j) { const int e = tid + 512 * j, t = e >> 4, r = e & 15; ALR[e] = (t < ntok) ? bf2f(Zg[(size_t)t * ZP + ALR_OFF + r]) : 0.f;
        const int rr = e >> 6, d = e & 63; WG[e] = wgu_g[rr * 256 + 64 * h + d]; }
    if (tid < 64) BG[tid] = bg_g[64 * h + tid];
    __syncthreads();
#pragma unroll
    for (int j = 0; j < 8; ++j) { const int e = tid + 512 * j, t = e >> 6, d = e & 63; float x = BG[d];
#pragma unroll
        for (int r = 0; r < 16; ++r) x += ALR[t * 16 + r] * WG[r * 64 + d];
        const float ls = fminf(x, 0.f) - __logf(1.f + __expf(-fabsf(x)));
        LA[t * 65 + d] = (t < ntok) ? ls * (1.f / 16.f) : 0.f; }
    __syncthreads();
    { const int d = tid & 63, sg = tid >> 6; float run = 0.f;
#pragma unroll
      for (int i = 0; i < 8; ++i) { run += LA[(8 * sg + i) * 65 + d]; LA[(8 * sg + i) * 65 + d] = run; }
      SEG[sg * 64 + d] = run;
      __syncthreads();
      float pre = 0.f;
#pragma unroll
      for (int q = 0; q < 8; ++q) pre += (q < sg) ? SEG[q * 64 + d] : 0.f;
#pragma unroll
      for (int i = 0; i < 8; ++i) LA[(8 * sg + i) * 65 + d] += pre; }
    __syncthreads();
    { f32x4 q0, q1, k0, k1; pg8::unpack8(qw, q0, q1); pg8::unpack8(kw, k0, k1); f32x4 e0, e1, f0, f1;
#pragma unroll
      for (int i = 0; i < 8; ++i) { const int d = pd8 + i; const float b = LA[pt * 65 + d], bl = LA[63 * 65 + d]; const float q = (i < 4) ? q0[i & 3] : q1[i & 3], k = (i < 4) ? k0[i & 3] : k1[i & 3];
          const float qe = q * __expf(b), ke = k * __expf(-b); if (i < 4) { e0[i & 3] = qe; f0[i & 3] = ke; } else { e1[i & 3] = qe; f1[i & 3] = ke; }
          KDT[d * 72 + pt] = (bf16_t)f2bf(k * __expf(bl - b)); }
      *(LAS u32x4*)(QE + pt * 72 + pd8) = pg8::pack8(e0, e1); *(LAS u32x4*)(KE + pt * 72 + pd8) = pg8::pack8(f0, f1); }
#pragma unroll
    for (int i = 0; i < 4; ++i) { const unsigned a0 = vw0[i], a1 = vw1[i];
        VT[(vc8 + 2 * i) * 72 + vt0] = (bf16_t)(a0 & 0xffffu); VT[(vc8 + 2 * i + 1) * 72 + vt0] = (bf16_t)(a0 >> 16);
        VT[(vc8 + 2 * i) * 72 + vt0 + 32] = (bf16_t)(a1 & 0xffffu); VT[(vc8 + 2 * i + 1) * 72 + vt0 + 32] = (bf16_t)(a1 >> 16); }
    if (MODE != 0) {
#pragma unroll
        for (int j = 0; j < 4; ++j) { const int idx = tid + 512 * j, d = idx >> 5, c4 = (idx & 31) * 4;
#pragma unroll
            for (int i = 0; i < 4; ++i) ST[(c4 + i) * 72 + d] = (bf16_t)f2bf(sw[j][i]); }
    }
    if (MODE == 0 && tid < 64) dec_g[tid] = __expf(LA[63 * 65 + tid]);
    __syncthreads();
    if (MODE != 1) { const int mb = wid >> 2, nb = wid & 3; f32x16 acc;
#pragma unroll
        for (int r = 0; r < 16; ++r) acc[r] = 0.f;
#pragma unroll
        for (int ks = 0; ks < 4; ++ks) { const bf16x8 a = *(const LAS bf16x8*)(KDT + (32 * mb + r32) * 72 + 16 * ks + 8 * hi), b = *(const LAS bf16x8*)(VT + (32 * nb + r32) * 72 + 16 * ks + 8 * hi);
            acc = __builtin_amdgcn_mfma_f32_32x32x16_bf16(a, b, acc, 0, 0, 0); }
#pragma unroll
        for (int r = 0; r < 16; ++r) { const int d = 32 * mb + crow(r, hi), e = 32 * nb + r32;
            if (MODE == 0) ds_g[d * 128 + e] = acc[r];
            else sf_g[d * 128 + e] = __expf(LA[63 * 65 + d]) * Sp_g[d * 128 + e] + acc[r]; }
    }
    if (MODE != 0) {
        if (wid < 4) { const int ib = wid >> 1, jb = wid & 1; f32x16 acc;
#pragma unroll
            for (int r = 0; r < 16; ++r) acc[r] = 0.f;
#pragma unroll
            for (int ks = 0; ks < 4; ++ks) { const bf16x8 a = *(const LAS bf16x8*)(QE + (32 * ib + r32) * 72 + 16 * ks + 8 * hi), b = *(const LAS bf16x8*)(KE + (32 * jb + r32) * 72 + 16 * ks + 8 * hi);
                acc = __builtin_amdgcn_mfma_f32_32x32x16_bf16(a, b, acc, 0, 0, 0); }
#pragma unroll
            for (int r = 0; r < 16; ++r) { const int i = 32 * ib + crow(r, hi), jj = 32 * jb + r32; ATT[i * 72 + jj] = (bf16_t)f2bf(jj <= i ? acc[r] : 0.f); }
        }
        __syncthreads();
        { const int ib = wid >> 2, eb = wid & 3; f32x16 acc;
#pragma unroll
          for (int r = 0; r < 16; ++r) acc[r] = 0.f;
#pragma unroll
          for (int ks = 0; ks < 4; ++ks) { const bf16x8 a = *(const LAS bf16x8*)(ATT + (32 * ib + r32) * 72 + 16 * ks + 8 * hi), b = *(const LAS bf16x8*)(VT + (32 * eb + r32) * 72 + 16 * ks + 8 * hi);
              acc = __builtin_amdgcn_mfma_f32_32x32x16_bf16(a, b, acc, 0, 0, 0); }
#pragma unroll
          for (int ks = 0; ks < 4; ++ks) { const bf16x8 a = *(const LAS bf16x8*)(QE + (32 * ib + r32) * 72 + 16 * ks + 8 * hi), b = *(const LAS bf16x8*)(ST + (32 * eb + r32) * 72 + 16 * ks + 8 * hi);
              acc = __builtin_amdgcn_mfma_f32_32x32x16_bf16(a, b, acc, 0, 0, 0); }
#pragma unroll
          for (int r = 0; r < 16; ++r) OB[(32 * ib + crow(r, hi)) * 132 + 32 * eb + r32] = acc[r];
        }
        __syncthreads();
        { const int i = tid >> 3, sg = tid & 7; float v[16]; float ss = 0.f;
#pragma unroll
          for (int c = 0; c < 16; ++c) { v[c] = OB[i * 132 + 16 * sg + c]; ss += v[c] * v[c]; }
          ss += __shfl_xor(ss, 1); ss += __shfl_xor(ss, 2); ss += __shfl_xor(ss, 4);
          const float rstd = __builtin_amdgcn_rsqf(ss * (1.f / 128.f) + 1e-5f);
          if (i < ntok) {
#pragma unroll
              for (int hh = 0; hh < 2; ++hh) { const u32x4 rw = hh ? rw1 : rw0; f32x4 r0, r1; pg8::unpack8(rw, r0, r1); f32x4 o0, o1;
#pragma unroll
                  for (int c = 0; c < 4; ++c) { const float g0 = gl_g[16 * sg + 8 * hh + c], g1 = gl_g[16 * sg + 8 * hh + 4 + c];
                      o0[c] = v[8 * hh + c] * rstd * g0 * r0[c] * pg8::fast_sigmoid(r0[c]); o1[c] = v[8 * hh + 4 + c] * rstd * g1 * r1[c] * pg8::fast_sigmoid(r1[c]); }
                  *(GAS u32x4*)(Oout + (size_t)i * OP + 16 * sg + 8 * hh) = pg8::pack8(o0, o1); } }
        }
    }
    __syncthreads();
}

__device__ __forceinline__ unsigned char* opq(unsigned char* p) { asm volatile("" : "+s"(p)); return p; }
__device__ __forceinline__ float* opqf(float* p) { asm volatile("" : "+s"(p)); return p; }
#define XB_TMO      128
#define XB_XCNT(j)  (256  + 64 * (j))
#define XB_XSUB(j)  (1280 + 64 * (j))
#define XB_XGEN(j)  (2304 + 64 * (j))
#define XB_TOP      3328
#define XB_TOPGEN   3392
#define XCD_BAR_WORDS 3456
#define XB_SPIN_CAP (1u << 18)

__device__ __forceinline__ unsigned xb_ld(unsigned* p)              { return __hip_atomic_load(p, __ATOMIC_RELAXED, __HIP_MEMORY_SCOPE_AGENT); }
__device__ __forceinline__ unsigned xb_add(unsigned* p, unsigned v) { return __hip_atomic_fetch_add(p, v, __ATOMIC_RELAXED, __HIP_MEMORY_SCOPE_AGENT); }
__device__ __forceinline__ unsigned xb_xcc_id() { return (unsigned)__builtin_amdgcn_s_getreg((3 << 11) | 20) & 0xFu; }
#define XB_SPIN(cond, bar) do { unsigned _sp = 0; while (cond) { __builtin_amdgcn_s_sleep(1); \
    if ((++_sp & 255u) == 0u) { if (xb_ld(&(bar)[XB_TMO])) break; if (_sp > XB_SPIN_CAP) { atomicAdd(&(bar)[XB_TMO], 1u); break; } } } } while (0)

struct XcdBarrier {
    unsigned* bar; unsigned x;
    volatile LAS unsigned* st;
};

__device__ __forceinline__ XcdBarrier xcd_barrier_post(unsigned* bar, volatile LAS unsigned* st) {
    XcdBarrier b; b.bar = bar; b.x = xb_xcc_id(); b.st = st;
    if (threadIdx.x == 0) (void)xb_add(&bar[XB_XCNT(b.x)], 1u);
    return b;
}
__device__ __forceinline__ void xcd_barrier_complete(unsigned* bar, unsigned x, unsigned& nloc, unsigned& nx) {
    const unsigned G = gridDim.x * gridDim.y * gridDim.z;
    unsigned sum, cnt, mine, sp = 0u;
    for (;;) {
        sum = 0u; cnt = 0u; mine = 0u;
#pragma unroll
        for (unsigned j = 0; j < 16; ++j) { const unsigned c = xb_ld(&bar[XB_XCNT(j)]); sum += c; cnt += (c > 0u) ? 1u : 0u; mine = (j == x) ? c : mine; }
        if (sum == G) break;
        __builtin_amdgcn_s_sleep(1);
        if ((++sp & 255u) == 0u) { if (xb_ld(&bar[XB_TMO])) break; if (sp > XB_SPIN_CAP) { atomicAdd(&bar[XB_TMO], 1u); break; } }
    }
    nloc = mine > 0u ? mine : 1u; nx = cnt > 0u ? cnt : 1u;
}

__device__ __forceinline__ void xcd_barrier(const XcdBarrier& b) {
    asm volatile("s_waitcnt vmcnt(0)" ::: "memory");
    __syncthreads();
    if (threadIdx.x == 0) {
        unsigned* bar = b.bar;
        __builtin_amdgcn_s_waitcnt(0);
        unsigned nloc = b.st[0], nx = b.st[1];
        if (nloc == 0u) { xcd_barrier_complete(bar, b.x, nloc, nx); b.st[0] = nloc; b.st[1] = nx; }
        const unsigned old = xb_add(&bar[XB_XSUB(b.x)], 1u);
        const unsigned gen = old / nloc;
        if (old + 1u == (gen + 1u) * nloc) {
            __builtin_amdgcn_fence(__ATOMIC_RELEASE, "agent");
            asm volatile("s_waitcnt vmcnt(0)" ::: "memory");
            const unsigned og = xb_add(&bar[XB_TOP], 1u);
            const unsigned tg = og / nx;
            if (og + 1u == (tg + 1u) * nx) xb_add(&bar[XB_TOPGEN], 1u);
            else XB_SPIN(xb_ld(&bar[XB_TOPGEN]) == tg, bar);
            __builtin_amdgcn_fence(__ATOMIC_ACQUIRE, "agent");
            xb_add(&bar[XB_XGEN(b.x)], 1u);
            asm volatile("s_waitcnt vmcnt(0)" ::: "memory");
        } else {
            XB_SPIN(xb_ld(&bar[XB_XGEN(b.x)]) == gen, bar);
            __builtin_amdgcn_fence(__ATOMIC_ACQUIRE, "agent");
            asm volatile("s_waitcnt vmcnt(0)" ::: "memory");
        }
    }
    __syncthreads();
}

template <class Epi> __device__ __forceinline__ void run_gemm(LAS unsigned char* lds, const bf16_t* A, const bf16_t* Bt, int M, int N, int K, const Epi& E) {
    pg8::Gemm g{A, Bt, M, N, K}; pg8::StaticOrder S; S.init(M, N, (int)gridDim.x, (int)blockIdx.x);
    pg8::gemm_phase<Epi, pg8::StaticOrder, true, true>(lds, g, S, E);
}

constexpr float QSCALE = 0.125f * 1.4426950408889634f;

__global__ void __launch_bounds__(512, 2) mega_fwd(Params P) {
    extern __shared__ __attribute__((aligned(16))) unsigned char lds_raw[];
    LAS unsigned char* lds = (LAS unsigned char*)lds_raw;
    cg::grid_group grid = cg::this_grid();
    int tid = threadIdx.x; asm volatile("" : "+v"(tid)); int lane = tid & 63, wid = __builtin_amdgcn_readfirstlane(tid >> 6);
    const int G = gridDim.x, bid = blockIdx.x, NGW = G * 8; int gw = bid * 8 + wid;
    unsigned char* wsl = opq(P.ws); float* outl = opqf(P.out);
#define NEWPHASE() do { wsl = opq(P.ws); outl = opqf(P.out); tid = threadIdx.x; asm volatile("" : "+v"(tid)); lane = tid & 63; wid = __builtin_amdgcn_readfirstlane(tid >> 6); gw = bid * 8 + wid; } while (0)
#define WSB() wsl
#define GSYNC() do { XcdBarrier b_; b_.bar = (unsigned*)(opq(P.ws) + W_CTR) + 1024; b_.x = xb_xcc_id(); b_.st = (volatile LAS unsigned*)(misc + 8); xcd_barrier(b_); NEWPHASE(); } while (0)
#define PB(off) ((bf16_t*)(WSB() + (off)))
#define PF(off) ((float*)(WSB() + (off)))
#define ctr ((unsigned*)(WSB() + W_CTR))
#define WGU PB(W_WGU)
#define WD PB(W_WD)
#define WIN PB(W_WIN)
#define WOA PB(W_WOA)
#define WOB PB(W_WOB)
#define WO PB(W_WO)
#define H PB(W_H)
#define ACT PB(W_ACT)
#define Y PB(W_Y)
#define Z PB(W_Z)
#define OA PB(W_OAB)
#define OB (PB(W_OAB) + (size_t)MALL * OP)
#define MIX PB(W_MIX)
#define KC PB(W_KC)
#define VC PB(W_VC)
#define DS PF(W_DS)
#define DEC PF(W_DEC)
#define ropec PF(W_ROPE)
#define ropes (PF(W_ROPE) + (size_t)MP * 32)
#define xbuf outl
    LAS unsigned* misc = (LAS unsigned*)(lds + LDS_MAIN);
    if (threadIdx.x < 4) misc[8 + threadIdx.x] = 0u;
    __syncthreads();
    (void)xcd_barrier_post((unsigned*)(P.ws + W_CTR) + 1024, (volatile LAS unsigned*)(misc + 8));
    if (P.ws == nullptr) grid.sync();

    { LAS float* finv = (LAS float*)(lds + LDS_MAIN + 256);
#pragma unroll
      for (int d = 0; d < 32; ++d) if (tid == d) finv[d] = P.inv_freq[d];
      __syncthreads();
      for (int idx = bid * 512 + tid; idx < MP * 32; idx += G * 512) { const int pos = idx >> 5, d = idx & 31; const float ang = (float)pos * finv[d];
          double rev = (double)ang * 0.15915494309189535; rev -= floor(rev); const float fr = (float)rev;
          ropec[idx] = __builtin_amdgcn_cosf(fr); ropes[idx] = __builtin_amdgcn_sinf(fr); }
      __syncthreads();
    }
    { LAS float* scr = (LAS float*)(lds + wid * 8448);
      for (int it = gw; it < 24320; it += NGW) { int r = it;
          if (r < 16896) { const int lf = r / 4224; r -= lf * 4224;
              if (r < 2816) transpose_item(P.w_gate + (size_t)lf * DM * DFF, P.w_up + (size_t)lf * DM * DFF, DFF, DM, 1, WGU + (size_t)lf * NGU * DM, scr, r, 176, lane);
              else transpose_item(P.w_down + (size_t)lf * DFF * DM, nullptr, DM, DFF, 0, WD + (size_t)lf * DM * DFF, scr, r - 2816, 32, lane);
          } else { r -= 16896; const int l = r / 3712; r -= l * 3712;
              if (r < 2688) transpose_item(P.w_in + (size_t)l * DM * 5136, nullptr, 5136, DM, 2, WIN + (size_t)l * ZP * DM, scr, r, 168, lane);
              else if (r < 2944) transpose_item(P.w_out_a + (size_t)l * 512 * DM, nullptr, DM, 512, 0, WOA + (size_t)l * DM * 512, scr, r - 2688, 32, lane);
              else if (r < 3200) transpose_item(P.w_out_b + (size_t)l * 512 * DM, nullptr, DM, 512, 0, WOB + (size_t)l * DM * 512, scr, r - 2944, 32, lane);
              else transpose_item(P.w_out + (size_t)l * DM * DM, nullptr, DM, DM, 0, WO + (size_t)l * DM * DM, scr, r - 3200, 32, lane); } }
    }
    rownorm_phase(P.x_prompt, P.x_sample, xbuf, nullptr, nullptr, 0.f, P.norm_g, H, gw, NGW, lane);
    GSYNC();

#pragma unroll
    for (int l = 0; l < 2; ++l) {
        const float* ng = P.norm_g + (size_t)l * 6 * DM;
        run_gemm(lds, H, WGU + (size_t)(l * 2) * NGU * DM, MALL, NGU, DM, pg8::EpiSwiGLU{ACT, DFF});
        GSYNC();
        run_gemm(lds, ACT, WD + (size_t)(l * 2) * DM * DFF, MP, DM, DFF, pg8::EpiPlain{Y, DM});
        gemm_small<0>(lds, ACT + (size_t)MP * DFF, WD + (size_t)(l * 2) * DM * DFF, DFF, nullptr, nullptr, 0, Y + (size_t)MP * DM, DM, nullptr);
        GSYNC();
        rownorm_phase(xbuf, xbuf + (size_t)MP * DM, xbuf, Y, ng + 1 * DM, 0.5f, ng + 2 * DM, H, gw, NGW, lane);
        GSYNC();
        {

                { pg8::EpiInProj E{Z, ZP, ropec, ropes, P.out + O_KP + (size_t)l * MP * 512, P.out + O_VP + (size_t)l * MP * 512, P.out + O_KS + (size_t)l * MS * 512, P.out + O_VS + (size_t)l * MS * 512,
                                   KC + (size_t)l * 32 * KCROWS * 512, VC + (size_t)l * 32 * KCROWS * 512, QSCALE};
                  run_gemm(lds, H, WIN + (size_t)l * ZP * DM, MALL, ZP, DM, E); }
                GSYNC();
#if defined(STOP_AT) && STOP_AT == 2
                return;
#endif
                const float* wgu = P.w_gate_up + (size_t)l * 16 * 256; const float* bgp = P.b_gate + (size_t)l * 256;
                for (int u = bid; u < NCHUNK * 4; u += G) { const int n = u >> 2, h = u & 3;
                    gla_unit<0>(lds, Z + (size_t)(64 * n) * ZP, 64, wgu, bgp, h, DS + (size_t)u * 8192, DEC + (size_t)u * 64, nullptr, nullptr, nullptr, nullptr); }
                GSYNC();
                { LAS float* SA = (LAS float*)lds; LAS float* SBv = SA + 512; const int el = tid & 127, sg = tid >> 7;
                  for (int base = bid * 128; base < 32768; base += G * 128) { const int gid = base + el, hd = gid >> 7, e = gid & 127;
                    GAS float* dsp = (GAS float*)(DS + (size_t)hd * 128 + e + (size_t)(64 * sg) * 32768); const GAS float* dcp = (const GAS float*)(DEC + hd + (64 * sg) * 256);
                    float A = 1.f, B = 0.f;
                    for (int n = 0; n < 64; n += 16) { float v[16], c[16];
#pragma unroll
                        for (int j = 0; j < 16; ++j) { v[j] = dsp[(size_t)(n + j) * 32768]; c[j] = dcp[(n + j) * 256]; }
#pragma unroll
                        for (int j = 0; j < 16; ++j) { B = c[j] * B + v[j]; A *= c[j]; } }
                    SA[sg * 128 + el] = A; SBv[sg * 128 + el] = B;
                    __syncthreads();
                    float S = 0.f;
#pragma unroll
                    for (int q = 0; q < 3; ++q) if (q < sg) S = SA[q * 128 + el] * S + SBv[q * 128 + el];
                    for (int n = 0; n < 64; n += 16) { float v[16], c[16];
#pragma unroll
                        for (int j = 0; j < 16; ++j) { v[j] = dsp[(size_t)(n + j) * 32768]; c[j] = dcp[(n + j) * 256]; }
#pragma unroll
                        for (int j = 0; j < 16; ++j) { const float prev = S; S = c[j] * S + v[j]; dsp[(size_t)(n + j) * 32768] = prev; } }
                    if (sg == 3) P.out[O_SP + (size_t)l * 32768 + gid] = S;
                    __syncthreads(); } }
                GSYNC();
                { int lq = l; asm volatile("" : "+s"(lq)); const float lam_init = (lq == 0) ? 0.2f : 0.35550906f; const float* lf = P.lambda_p + (size_t)l * 256;
                  const float lam_v = __expf(wave_sum(lf[lane] * lf[64 + lane])) - __expf(wave_sum(lf[128 + lane] * lf[192 + lane])) + lam_init;
                  const float lam = __uint_as_float(__builtin_amdgcn_readfirstlane(__float_as_uint(lam_v)));
                  const float osc = __uint_as_float(__builtin_amdgcn_readfirstlane(__float_as_uint(1.f - lam_init)));
                  const float* subg = P.subln_g + (size_t)l * 128; const float* glang = P.gla_norm_g + (size_t)l * 128;
                  const bf16_t* KCl = KC + (size_t)l * 32 * KCROWS * 512; const bf16_t* VCl = VC + (size_t)l * 32 * KCROWS * 512;
                  const unsigned hq0 = xb_xcc_id() & 3u; unsigned exh = 0u;
                  for (;;) {
                      if (tid == 0) { unsigned code = 0xffffffffu;
                          for (unsigned kq = 0; kq < 4u && code == 0xffffffffu; ++kq) { const unsigned hh = (hq0 + kq) & 3u;
                              if (!((exh >> hh) & 1u)) { const unsigned idx = atomicAdd(&ctr[l * 16 + hh], 1u); if (idx < 160u) code = (idx < 112u) ? ((127u - idx) * 4u + hh) : (idx < 144u) ? (512u + (idx - 112u) * 4u + hh) : ((15u - (idx - 144u)) * 4u + hh); else exh |= 1u << hh; } }
                          if (code == 0xffffffffu) { const unsigned idx = atomicAdd(&ctr[l * 16 + 4], 1u); if (idx < 1152u) code = 640u + idx; }
                          misc[0] = code; }
                      __syncthreads();
                      const unsigned u = misc[0];
                      __syncthreads();
                      if (u == 0xffffffffu) break;
                      if (u < 640u) {
#ifndef SKIP_ATTN
                          int smp = 0, qb = 0, h = (int)(u & 3), b = 0;
                          if (u < 512u) qb = (int)(u >> 2); else { smp = 1; b = (int)((u - 512u) >> 2); }
                          if (!smp) { const int q0 = 128 * qb;
                              attn_unit(lds, Z + (size_t)q0 * ZP + QA_OFF + 128 * h, ZP, 127, Z + KA_OFF + 128 * h, Z + VA_OFF + 128 * h, ZP, nullptr, nullptr, 2 * qb + 2, 64, 0, q0, OA + (size_t)q0 * OP + 128 * h, 128, lam, subg, osc);
                          } else { const int R0 = MP + 16 * b;
                              attn_unit(lds, Z + (size_t)R0 * ZP + QA_OFF + 128 * h, ZP, 15, KCl + (size_t)b * KCROWS * 512 + 128 * h, VCl + (size_t)b * KCROWS * 512 + 128 * h, 512, P.cache_k + ((size_t)(l * 32 + b) * PAST) * 512 + 128 * h, P.cache_v + ((size_t)(l * 32 + b) * PAST) * 512 + 128 * h, 33, 16, 1, 0, OA + (size_t)R0 * OP + 128 * h, 16, lam, subg, osc); }
#endif
                      } else if (u < 1664u) { const int v = (int)u - 640, n = v >> 2, h = v & 3;
#ifndef SKIP_GLA12
                          gla_unit<1>(lds, Z + (size_t)(64 * n) * ZP, 64, wgu, bgp, h, nullptr, nullptr, DS + (size_t)v * 8192, nullptr, glang, OB + (size_t)(64 * n) * OP + 128 * h);
#endif
                      } else { const int v = (int)u - 1664, b = v >> 2, h = v & 3; const int R0 = MP + 16 * b;
#ifndef SKIP_GLA12
                          gla_unit<2>(lds, Z + (size_t)R0 * ZP, 16, wgu, bgp, h, nullptr, nullptr, P.state_gla + ((size_t)(l * 32 + b) * 4 + h) * 8192, P.out + O_SS + ((size_t)(l * 32 + b) * 4 + h) * 8192, glang, OB + (size_t)R0 * OP + 128 * h);
#endif
 }
                  } }
                GSYNC();
                run_gemm(lds, OA, WOA + (size_t)l * DM * 512, MP, DM, 512, pg8::EpiGate<false>{MIX, nullptr, DM, Z + GA_OFF, ZP});
                run_gemm(lds, OB, WOB + (size_t)l * DM * 512, MP, DM, 512, pg8::EpiGate<true>{MIX, MIX, DM, Z + GB_OFF, ZP});
                gemm_small<1>(lds, OA + (size_t)MP * OP, WOA + (size_t)l * DM * 512, 512, OB + (size_t)MP * OP, WOB + (size_t)l * DM * 512, 512, MIX + (size_t)MP * DM, DM, Z + (size_t)MP * ZP);
                GSYNC();
                run_gemm(lds, MIX, WO + (size_t)l * DM * DM, MP, DM, DM, pg8::EpiPlain{Y, DM});
                gemm_small<0>(lds, MIX + (size_t)MP * DM, WO + (size_t)l * DM * DM, DM, nullptr, nullptr, 0, Y + (size_t)MP * DM, DM, nullptr);
                GSYNC();
                rownorm_phase(xbuf, xbuf + (size_t)MP * DM, xbuf, Y, ng + 3 * DM, 1.0f, ng + 4 * DM, H, gw, NGW, lane);
                GSYNC();
#if defined(STOP_AT) && STOP_AT == 4
                return;
#endif

        }
        run_gemm(lds, H, WGU + (size_t)(l * 2 + 1) * NGU * DM, MALL, NGU, DM, pg8::EpiSwiGLU{ACT, DFF});
        GSYNC();
        run_gemm(lds, ACT, WD + (size_t)(l * 2 + 1) * DM * DFF, MP, DM, DFF, pg8::EpiPlain{Y, DM});
        gemm_small<0>(lds, ACT + (size_t)MP * DFF, WD + (size_t)(l * 2 + 1) * DM * DFF, DFF, nullptr, nullptr, 0, Y + (size_t)MP * DM, DM, nullptr);
        GSYNC();
        if (l == 0) { rownorm_phase(xbuf, xbuf + (size_t)MP * DM, xbuf, Y, ng + 5 * DM, 0.5f, P.norm_g + 6 * DM, H, gw, NGW, lane); GSYNC(); }
        else rownorm_phase(xbuf, xbuf + (size_t)MP * DM, xbuf, Y, ng + 5 * DM, 0.5f, nullptr, nullptr, gw, NGW, lane);
    }
}

#undef WSB
#undef NEWPHASE
#undef GSYNC
#undef PB
#undef PF
#undef ctr
#undef WGU
#undef WD
#undef WIN
#undef WOA
#undef WOB
#undef WO
#undef H
#undef ACT
#undef Y
#undef Z
#undef OA
#undef OB
#undef MIX
#undef KC
#undef VC
#undef DS
#undef DEC
#undef ropec
#undef ropes
#undef xbuf
extern "C" void kernel_launch(void* const* d_in, const int* in_sizes, int n_in, void* d_out, int out_size, void* d_ws, size_t ws_size, hipStream_t stream) {
    static int grid_blocks = 0;
    if (grid_blocks == 0) {
        if (n_in != 18 || (size_t)out_size != O_END || ws_size < W_END) { fprintf(stderr, "kernel_launch: unexpected sizes n_in %d out %d ws %zu (need %zu)\n", n_in, out_size, ws_size, (size_t)W_END); grid_blocks = -1; return; }
        int dev = 0, cus = 0, per_cu = 0;
        hipGetDevice(&dev); hipDeviceGetAttribute(&cus, hipDeviceAttributeMultiprocessorCount, dev);
        if (hipFuncSetAttribute((const void*)mega_fwd, hipFuncAttributeMaxDynamicSharedMemorySize, LDS_TOTAL) != hipSuccess) { fprintf(stderr, "kernel_launch: hipFuncSetAttribute failed\n"); grid_blocks = -1; return; }
        if (hipOccupancyMaxActiveBlocksPerMultiprocessor(&per_cu, (const void*)mega_fwd, 512, LDS_TOTAL) != hipSuccess || per_cu < 1) { fprintf(stderr, "kernel_launch: occupancy query gave %d\n", per_cu); per_cu = 1; }
        (void)hipGetLastError();
        grid_blocks = cus * 1;
    }
    if (grid_blocks < 0) return;
    Params p{};
    const float** pp = (const float**)&p;
    for (int i = 0; i < 18; ++i) pp[i] = (const float*)d_in[i];
    p.out = (float*)d_out; p.ws = (unsigned char*)d_ws;
    for (int d = 0; d < 32; ++d) p.inv_freq[d] = (float)exp(-log(10000.0) * (double)d / 32.0);
    if (hipMemsetAsync((char*)d_ws + W_CTR, 0, 65536, stream) != hipSuccess) { fprintf(stderr, "kernel_launch: memset failed\n"); return; }
    void* args[] = {&p};
    hipError_t e = hipLaunchCooperativeKernel((const void*)mega_fwd, dim3(grid_blocks), dim3(512), args, LDS_TOTAL, stream);
    if (e != hipSuccess) fprintf(stderr, "cooperative launch failed: %s (grid %d)\n", hipGetErrorString(e), grid_blocks);
}
```

```cpp
#include <hip/hip_runtime.h>
#include <hip/hip_cooperative_groups.h>
#include <cstdio>
#include <cstdint>
#include <cmath>
namespace cg = cooperative_groups;
#define GAS __attribute__((address_space(1)))
namespace pg8 {
#define PG8_LAS __attribute__((address_space(3)))
typedef unsigned short bf16_t;
typedef short bf16x8 __attribute__((ext_vector_type(8)));
typedef float f32x4 __attribute__((ext_vector_type(4)));
typedef unsigned u32x4 __attribute__((ext_vector_type(4)));
constexpr int BM = 256, BK = 64, HALF = 128, HTB = HALF * BK * 2  , STAGE_BYTES = 8 * HTB, NXCD = 8, WGM = 8;

__host__ __device__ __forceinline__ int lds_byte(int r, int c) { const int st = (r >> 4) * 2 + (c >> 5), rr = r & 15, cc = c & 31, ob = rr * 64 + cc * 2; return st * 1024 + (ob ^ (((ob >> 9) & 1) << 5)); }
__host__ __device__ __forceinline__ void stage_rc(int b, int& R, int& C) { const int st = b / 1024, sb = b % 1024, swz = sb ^ (((sb >> 9) & 1) << 5); R = (st >> 1) * 16 + swz / 64; C = (st & 1) * 32 + (swz % 64) / 2; }
__host__ __device__ __forceinline__ int perm32(int rho) { const int n = rho >> 4, i = rho & 15; return 8 * (i >> 2) + 4 * n + (i & 3); }

struct Unit { int pm, pn; };
struct Gemm { const bf16_t* A; const bf16_t* Bt; int M, N, K; };

struct StaticOrder {
    int nM, nN, nwg, G, c;
    __host__ __device__ void init(int M, int N, int G_, int c_) { nM = M / BM; nN = N / BM; nwg = nM * nN; G = G_; c = c_; }
    __host__ __device__ bool next(int i, Unit& u) const {
        const long L = (long)i * G + c; if (L >= nwg) return false;
        int wgid = (int)L; { const int q = nwg / NXCD, r = nwg % NXCD, xcd = wgid % NXCD, off = wgid / NXCD; wgid = (xcd < r ? xcd * (q + 1) : r * (q + 1) + (xcd - r) * q) + off; }
        const int nig = WGM * nN, gid = wgid / nig, fm = gid * WGM, gsz = (nM - fm) < WGM ? (nM - fm) : WGM;
        u.pm = fm + ((wgid % nig) % gsz); u.pn = (wgid % nig) / gsz; return true;
    }
    __device__ __forceinline__ void a_ready(const Unit&) const {}
    __device__ __forceinline__ void done(const Unit&) const {}
};

__device__ __forceinline__ unsigned cvt_pk_bf16(float lo, float hi) { unsigned r; asm volatile("v_cvt_pk_bf16_f32 %0, %1, %2" : "=v"(r) : "v"(lo), "v"(hi)); return r; }
typedef float f32x2 __attribute__((ext_vector_type(2)));
__device__ __forceinline__ float fast_sigmoid(float x) { return __builtin_amdgcn_rcpf(1.0f + __builtin_amdgcn_exp2f(-1.4426950408889634f * x)); }
__device__ __forceinline__ float bf2f(bf16_t b) { return __uint_as_float(((unsigned)b) << 16); }
__device__ __forceinline__ u32x4 pack8(const f32x4& v0, const f32x4& v1) { u32x4 w; w.x = cvt_pk_bf16(v0[0], v0[1]); w.y = cvt_pk_bf16(v0[2], v0[3]); w.z = cvt_pk_bf16(v1[0], v1[1]); w.w = cvt_pk_bf16(v1[2], v1[3]); return w; }
__device__ __forceinline__ void unpack8(const u32x4& w, f32x4& v0, f32x4& v1) {
    v0[0] = __uint_as_float(w.x << 16); v0[1] = __uint_as_float(w.x & 0xffff0000u); v0[2] = __uint_as_float(w.y << 16); v0[3] = __uint_as_float(w.y & 0xffff0000u);
    v1[0] = __uint_as_float(w.z << 16); v1[1] = __uint_as_float(w.z & 0xffff0000u); v1[2] = __uint_as_float(w.w << 16); v1[3] = __uint_as_float(w.w & 0xffff0000u); }

struct EpiPlain {
    static constexpr bool PERM = true, AFTER_DRAIN = false;
    bf16_t* O; int ldc;
    __device__ __forceinline__ void operator()(const f32x4 (&acc)[2][2][4][2], const Unit& u, int wr, int wc, int fr, int fq) const {
        const int row0 = u.pm * BM + wr * 64 + fr, col0 = u.pn * BM + wc * 32 + 8 * fq;
#pragma unroll
        for (int ai = 0; ai < 2; ++ai)
#pragma unroll
            for (int m = 0; m < 4; ++m) { bf16_t* rowp = O + (size_t)(row0 + ai * HALF + m * 16) * ldc + col0;
#pragma unroll
                for (int bj = 0; bj < 2; ++bj) *(GAS u32x4*)(rowp + bj * HALF) = pack8(acc[ai][bj][m][0], acc[ai][bj][m][1]); }
    }
};
struct EpiSwiGLU {
    static constexpr bool PERM = true, AFTER_DRAIN = false;
    bf16_t* O; int ldc;
    __device__ __forceinline__ void operator()(const f32x4 (&acc)[2][2][4][2], const Unit& u, int wr, int wc, int fr, int fq) const {
        const int row0 = u.pm * BM + wr * 64 + fr, col0 = u.pn * HALF + wc * 32 + 8 * fq;
#pragma unroll
        for (int ai = 0; ai < 2; ++ai)
#pragma unroll
            for (int m = 0; m < 4; ++m) { bf16_t* rowp = O + (size_t)(row0 + ai * HALF + m * 16) * ldc + col0;
                f32x4 r0, r1;
#pragma unroll
                for (int i = 0; i < 4; ++i) { const float g0 = acc[ai][0][m][0][i], g1 = acc[ai][0][m][1][i];
                    r0[i] = g0 * fast_sigmoid(g0) * acc[ai][1][m][0][i]; r1[i] = g1 * fast_sigmoid(g1) * acc[ai][1][m][1][i]; }
                *(GAS u32x4*)rowp = pack8(r0, r1); }
    }
};
template <bool ADD> struct EpiGate {
    static constexpr bool PERM = true, AFTER_DRAIN = false;
    bf16_t* O; const bf16_t* P; int ldc; const bf16_t* G; int ldg;
    __device__ __forceinline__ void operator()(const f32x4 (&acc)[2][2][4][2], const Unit& u, int wr, int wc, int fr, int fq) const {
        const int row0 = u.pm * BM + wr * 64 + fr, col0 = u.pn * BM + wc * 32 + 8 * fq;
        u32x4 gq[2][2], pq[2][2];
#define EG_LOAD(IT, SL) do { const size_t row_ = (size_t)(row0 + ((IT) >> 2) * HALF + ((IT) & 3) * 16); \
            _Pragma("unroll") for (int bj = 0; bj < 2; ++bj) { gq[SL][bj] = *(const GAS u32x4*)(G + row_ * ldg + col0 + bj * HALF); if (ADD) pq[SL][bj] = *(const GAS u32x4*)(P + row_ * ldc + col0 + bj * HALF); } } while (0)
        EG_LOAD(0, 0);
#pragma unroll
        for (int it = 0; it < 8; ++it) { const int ai = it >> 2, m = it & 3; const size_t row = (size_t)(row0 + ai * HALF + m * 16);
            if (it + 1 < 8) { if ((it & 1) == 0) EG_LOAD(it + 1, 1); else EG_LOAD(it + 1, 0); }
#pragma unroll
            for (int bj = 0; bj < 2; ++bj) { const int col = col0 + bj * HALF;
                f32x4 g0, g1; unpack8(gq[it & 1][bj], g0, g1);
                f32x4 p0 = {0.f, 0.f, 0.f, 0.f}, p1 = {0.f, 0.f, 0.f, 0.f};
                if (ADD) unpack8(pq[it & 1][bj], p0, p1);
                f32x4 r0, r1;
#pragma unroll
                for (int i = 0; i < 4; ++i) { r0[i] = p0[i] + fast_sigmoid(g0[i]) * acc[ai][bj][m][0][i]; r1[i] = p1[i] + fast_sigmoid(g1[i]) * acc[ai][bj][m][1][i]; }
                *(GAS u32x4*)(O + row * ldc + col) = pack8(r0, r1); }
            asm volatile("" ::: "memory"); }
#undef EG_LOAD
    }
};
typedef unsigned u32x2 __attribute__((ext_vector_type(2)));
struct EpiInProj {
    static constexpr bool PERM = true, AFTER_DRAIN = false;
    bf16_t* Z; int ldz; const float* ropec; const float* ropes;
    float* kout_p; float* vout_p; float* kout_s; float* vout_s; bf16_t* KC; bf16_t* VC; float qscale;
    __device__ __forceinline__ void operator()(const f32x4 (&acc)[2][2][4][2], const Unit& u, int wr, int wc, int fr, int fq) const {
        const int pn = u.pn; const int row0 = u.pm * BM + wr * 64 + fr;
        if (pn < 4) {
            const bool isk = pn >= 2; const int sec = isk ? 512 : 0, pnl = pn & 1, dbase = 16 * (wc & 1) + 4 * fq;
            f32x4 csq[2], snq[2];
#define EI_LOAD(IT, SL) do { const int row_ = row0 + ((IT) >> 2) * HALF + ((IT) & 3) * 16; const int pos_ = (row_ >= 16384) ? 2048 + ((row_ - 16384) & 15) : row_; \
                csq[SL] = *(const GAS f32x4*)(ropec + pos_ * 32 + dbase); snq[SL] = *(const GAS f32x4*)(ropes + pos_ * 32 + dbase); } while (0)
            EI_LOAD(0, 0);
#pragma unroll
            for (int it = 0; it < 8; ++it) { const int ai = it >> 2, m = it & 3; const int row = row0 + ai * HALF + m * 16; const bool smp = row >= 16384; const int sr = row - 16384;
                    if (it + 1 < 8) { if ((it & 1) == 0) EI_LOAD(it + 1, 1); else EI_LOAD(it + 1, 0); }
                    const f32x4 cs = csq[it & 1], sn = snq[it & 1];
#pragma unroll
                    for (int bj = 0; bj < 2; ++bj) { const int head = 4 * pnl + 2 * bj + (wc >> 1);
                        const f32x4 a0 = acc[ai][bj][m][0], a1 = acc[ai][bj][m][1];
                        const f32x4 x1 = {a0[0], a0[2], a1[0], a1[2]}, x2 = {a0[1], a0[3], a1[1], a1[3]};
                        f32x4 y1 = x1 * cs - x2 * sn, y2 = x2 * cs + x1 * sn;
                        const int hc = head * 64 + dbase;
                        if (isk) {
                            float* ko = smp ? kout_s + (size_t)sr * 512 + hc : kout_p + (size_t)row * 512 + hc;
                            *(GAS f32x4*)ko = y1; *(GAS f32x4*)(ko + 32) = y2;
                        } else { y1 = y1 * qscale; y2 = y2 * qscale; }
                        u32x2 w1, w2; w1.x = cvt_pk_bf16(y1[0], y1[1]); w1.y = cvt_pk_bf16(y1[2], y1[3]); w2.x = cvt_pk_bf16(y2[0], y2[1]); w2.y = cvt_pk_bf16(y2[2], y2[3]);
                        bf16_t* zp = Z + (size_t)row * ldz + sec + hc; *(GAS u32x2*)zp = w1; *(GAS u32x2*)(zp + 32) = w2;
                        if (isk && smp) { bf16_t* kc = KC + ((size_t)(sr >> 4) * 2112 + 2048 + (sr & 15)) * 512 + hc; *(GAS u32x2*)kc = w1; *(GAS u32x2*)(kc + 32) = w2; } }
                    asm volatile("" ::: "memory"); }
#undef EI_LOAD
        } else {
            const int col0 = pn * BM + wc * 32 + 8 * fq; const float sc = (pn == 6) ? 0.125f : 1.0f; const bool isv = (pn == 4 || pn == 5);
#pragma unroll
            for (int ai = 0; ai < 2; ++ai)
#pragma unroll
                for (int m = 0; m < 4; ++m) { const int row = row0 + ai * HALF + m * 16; const bool smp = row >= 16384; const int sr = row - 16384;
#pragma unroll
                    for (int bj = 0; bj < 2; ++bj) { const int col = col0 + bj * HALF;
                        const f32x4 v0 = acc[ai][bj][m][0] * sc, v1 = acc[ai][bj][m][1] * sc; const u32x4 w = pack8(v0, v1);
                        *(GAS u32x4*)(Z + (size_t)row * ldz + col) = w;
                        if (isv) { const int vc = col - 1024; float* vo = smp ? vout_s + (size_t)sr * 512 + vc : vout_p + (size_t)row * 512 + vc;
                            *(GAS f32x4*)vo = v0; *(GAS f32x4*)(vo + 4) = v1;
                            if (smp) *(GAS u32x4*)(VC + ((size_t)(sr >> 4) * 2112 + 2048 + (sr & 15)) * 512 + vc) = w; } }
                    asm volatile("" ::: "memory"); }
        }
    }
};

struct PanelRms {
    unsigned* xs;
    unsigned* cnt;
    float eps;
    __device__ __forceinline__ void run(const f32x4 (&v)[2][2][4][2], const Unit& u, int wr, int wc, int fr, int fq, PG8_LAS unsigned char* lds, int wid, int lane) const {
        PG8_LAS float* P = (PG8_LAS float*)lds;
        PG8_LAS float* S = (PG8_LAS float*)(lds + 4096);
#pragma unroll
        for (int ai = 0; ai < 2; ++ai)
#pragma unroll
            for (int m = 0; m < 4; ++m) { float s = 0.f;
#pragma unroll
                for (int bj = 0; bj < 2; ++bj)
#pragma unroll
                    for (int n = 0; n < 2; ++n) { const f32x4 x = v[ai][bj][m][n]; s += (x[0] * x[0] + x[1] * x[1]) + (x[2] * x[2] + x[3] * x[3]); }
                s += __shfl_xor(s, 16); s += __shfl_xor(s, 32);
                if (fq == 0) P[(ai * HALF + wr * 64 + m * 16 + fr) * 4 + wc] = s; }
        asm volatile("s_waitcnt lgkmcnt(0)" ::: "memory"); __builtin_amdgcn_s_barrier(); asm volatile("" ::: "memory");
        const int row = wid * 32 + (lane & 31);
        if (lane < 32) { const float tot = (P[row * 4 + 0] + P[row * 4 + 1]) + (P[row * 4 + 2] + P[row * 4 + 3]);
            __hip_atomic_store(xs + (size_t)(u.pm * BM + row) * 4 + u.pn, __float_as_uint(tot), __ATOMIC_RELAXED, __HIP_MEMORY_SCOPE_AGENT); }
        asm volatile("s_waitcnt vmcnt(0)" ::: "memory");
        if (lane == 0) __hip_atomic_fetch_add(cnt + 64 * u.pm, 1u, __ATOMIC_RELAXED, __HIP_MEMORY_SCOPE_AGENT);
        if (wid == 0) { unsigned sp = 0u;
            while ((unsigned)__builtin_amdgcn_readfirstlane(__hip_atomic_load(cnt + 64 * u.pm, __ATOMIC_RELAXED, __HIP_MEMORY_SCOPE_AGENT)) < 32u) { __builtin_amdgcn_s_sleep(2); if (++sp > (1u << 22)) break; }
            __builtin_amdgcn_fence(__ATOMIC_ACQUIRE, "agent"); }
        asm volatile("s_waitcnt vmcnt(0) lgkmcnt(0)" ::: "memory"); __builtin_amdgcn_s_barrier(); asm volatile("" ::: "memory");
        if (lane < 32) { const unsigned* sl = xs + (size_t)(u.pm * BM + row) * 4; float t = 0.f;
#pragma unroll
            for (int k = 0; k < 4; ++k) t += __uint_as_float(__hip_atomic_load(sl + k, __ATOMIC_RELAXED, __HIP_MEMORY_SCOPE_AGENT));
            S[row] = __builtin_amdgcn_rsqf(t * (1.0f / 1024.0f) + eps); }
        asm volatile("s_waitcnt lgkmcnt(0)" ::: "memory"); __builtin_amdgcn_s_barrier(); asm volatile("" ::: "memory");
    }
};
struct EpiRmsRes {
    static constexpr bool PERM = false, AFTER_DRAIN = true;
    float* x; bf16_t* H; int ldc; const float* ga; float cy; const float* gb; PanelRms st1, st2;
    __device__ __forceinline__ void fused(f32x4 (&acc)[2][2][4][2], const Unit& u, int wr, int wc, int fr, int fq, PG8_LAS unsigned char* lds, int wid, int lane) const {
        const PG8_LAS float* S = (const PG8_LAS float*)(lds + 4096);
        const int col0 = u.pn * BM + wc * 32 + 4 * fq;
        st1.run(acc, u, wr, wc, fr, fq, lds, wid, lane);
        { f32x4 g1[2][2];
#pragma unroll
          for (int bj = 0; bj < 2; ++bj)
#pragma unroll
              for (int n = 0; n < 2; ++n) g1[bj][n] = *(const GAS f32x4*)(ga + col0 + bj * HALF + n * 16) * cy;
#pragma unroll
          for (int ai = 0; ai < 2; ++ai)
#pragma unroll
              for (int m = 0; m < 4; ++m) { const int r = ai * HALF + wr * 64 + m * 16 + fr; const float sr = S[r]; const size_t off = (size_t)(u.pm * BM + r) * ldc + col0;
#pragma unroll
                  for (int bj = 0; bj < 2; ++bj)
#pragma unroll
                      for (int n = 0; n < 2; ++n) { const f32x4 bs = *(const GAS f32x4*)(x + off + bj * HALF + n * 16); acc[ai][bj][m][n] = bs + acc[ai][bj][m][n] * g1[bj][n] * sr; }
                  asm volatile("" : "+v"(acc[ai][0][m][0]), "+v"(acc[ai][0][m][1]), "+v"(acc[ai][1][m][0]), "+v"(acc[ai][1][m][1]));
                  if (m & 1) asm volatile("" ::: "memory"); } }
        const bool two = (gb != nullptr);
        if (two) st2.run(acc, u, wr, wc, fr, fq, lds, wid, lane);
        f32x4 g2[2][2];
#pragma unroll
        for (int bj = 0; bj < 2; ++bj)
#pragma unroll
            for (int n = 0; n < 2; ++n) g2[bj][n] = two ? *(const GAS f32x4*)(gb + col0 + bj * HALF + n * 16) : (f32x4){0.f, 0.f, 0.f, 0.f};
#pragma unroll
        for (int ai = 0; ai < 2; ++ai)
#pragma unroll
            for (int m = 0; m < 4; ++m) { const int r = ai * HALF + wr * 64 + m * 16 + fr; const float sr = S[r]; const size_t off = (size_t)(u.pm * BM + r) * ldc + col0;
#pragma unroll
                for (int bj = 0; bj < 2; ++bj)
#pragma unroll
                    for (int n = 0; n < 2; ++n) { const f32x4 x1 = acc[ai][bj][m][n]; *(GAS f32x4*)(x + off + bj * HALF + n * 16) = x1;
                        if (two) { const f32x4 o = x1 * g2[bj][n] * sr; u32x2 w; w.x = cvt_pk_bf16(o[0], o[1]); w.y = cvt_pk_bf16(o[2], o[3]); *(GAS u32x2*)(H + off + bj * HALF + n * 16) = w; } }
                asm volatile("" ::: "memory"); }
    }
};
template <class Epi, class Sched, bool ALIGN_EPI = false, bool SP2 = false>
__device__ __forceinline__ void gemm_phase(PG8_LAS unsigned char* lds, const Gemm g, const Sched& S, const Epi& E) {
    int tid_ = threadIdx.x; asm volatile("" : "+v"(tid_));
    const int tid = tid_, wid = __builtin_amdgcn_readfirstlane(tid >> 6), lane = tid & 63, wr = wid >> 2, wc = wid & 3, fr = lane & 15, fq = lane >> 4;
    const int K = g.K, nt = K / BK;
    unsigned voffA[2], voffB[2];
#pragma unroll
    for (int i = 0; i < 2; ++i) { int R, C; stage_rc(tid * 16 + i * 8192, R, C); const int Rb = Epi::PERM ? ((R & ~31) + perm32(R & 31)) : R;
        voffA[i] = (unsigned)(R * K + C) * 2u; voffB[i] = (unsigned)(Rb * K + C) * 2u; }
    const size_t kstep = (size_t)(BK * 2);
    const size_t hstep = (size_t)HALF * K * 2;
    const size_t tstep = 2 * hstep;
    const unsigned ldsw = (unsigned)wid * 1024u;
    const int aoff = lds_byte(wr * 64 + fr, fq * 8), boff = lds_byte(wc * 32 + fr, fq * 8);
#define PG8_SA(b, h) (((b) * 2 + (h)) * HTB)
#define PG8_SB(b, h) ((4 + (b) * 2 + (h)) * HTB)
#define PG8_STAGE(bufoff, gbase, voff) do { _Pragma("unroll") for (int _i = 0; _i < 2; ++_i) \
        __builtin_amdgcn_global_load_lds((const unsigned*)((const char*)(gbase) + (voff)[_i]), (PG8_LAS unsigned*)(lds + (bufoff) + ldsw + _i * 8192), 16, 0, 0); } while (0)
#define PG8_LDA(dst, b, h) do { _Pragma("unroll") for (int m = 0; m < 4; ++m) _Pragma("unroll") for (int k = 0; k < 2; ++k) dst[m][k] = *(const PG8_LAS bf16x8*)(lds + PG8_SA(b, h) + aoff + m * 2048 + k * 1024); } while (0)
#define PG8_LDB(dst, b, h) do { _Pragma("unroll") for (int n = 0; n < 2; ++n) _Pragma("unroll") for (int k = 0; k < 2; ++k) dst[n][k] = *(const PG8_LAS bf16x8*)(lds + PG8_SB(b, h) + boff + n * 2048 + k * 1024); } while (0)
#define PG8_MMA(ai, bj, At, Bt) do { __builtin_amdgcn_s_setprio(1); _Pragma("unroll") for (int m = 0; m < 4; ++m) _Pragma("unroll") for (int n = 0; n < 2; ++n) _Pragma("unroll") for (int k = 0; k < 2; ++k) \
        acc[ai][bj][m][n] = __builtin_amdgcn_mfma_f32_16x16x32_bf16(Bt[n][k], At[m][k], acc[ai][bj][m][n], 0, 0, 0); __builtin_amdgcn_s_setprio(0); } while (0)
#define PG8_WAIT_V(n) asm volatile("s_waitcnt vmcnt(" #n ")" ::: "memory")
#define PG8_WAIT_L(n) asm volatile("s_waitcnt lgkmcnt(" #n ")" ::: "memory")
#define PG8_BAR __builtin_amdgcn_s_barrier()
#define PG8_SCHED __builtin_amdgcn_sched_barrier(0)
    Unit cur, nxt; int ui = 0;
    if (!S.next(0, cur)) return;
    f32x4 acc[2][2][4][2];
#pragma unroll
    for (int a = 0; a < 2; ++a)
#pragma unroll
        for (int b = 0; b < 2; ++b)
#pragma unroll
            for (int m = 0; m < 4; ++m)
#pragma unroll
                for (int n = 0; n < 2; ++n) acc[a][b][m][n] = (f32x4){0.f, 0.f, 0.f, 0.f};
    bf16x8 At[4][2], B0[2][2], B1[2][2];
    const char* cA = (const char*)g.A + (size_t)cur.pm * tstep; const char* cB = (const char*)g.Bt + (size_t)cur.pn * tstep;
    S.a_ready(cur);
    if constexpr (SP2) {
        PG8_STAGE(PG8_SB(0, 0), cB, voffB); PG8_STAGE(PG8_SB(0, 1), cB + hstep, voffB); PG8_STAGE(PG8_SA(0, 0), cA, voffA); PG8_STAGE(PG8_SA(0, 1), cA + hstep, voffA);
        if (wr == 1) PG8_BAR;
        PG8_WAIT_V(2); PG8_BAR;
        PG8_STAGE(PG8_SB(1, 0), cB + kstep, voffB); PG8_STAGE(PG8_SA(1, 0), cA + kstep, voffA); PG8_STAGE(PG8_SB(1, 1), cB + hstep + kstep, voffB);
        PG8_WAIT_V(6); PG8_BAR;
    } else {
        PG8_STAGE(PG8_SB(0, 0), cB, voffB); PG8_STAGE(PG8_SA(0, 0), cA, voffA); PG8_STAGE(PG8_SB(0, 1), cB + hstep, voffB); PG8_STAGE(PG8_SA(0, 1), cA + hstep, voffA);
        if (wr == 1) PG8_BAR;
        PG8_WAIT_V(4); PG8_BAR;
        PG8_STAGE(PG8_SB(1, 0), cB + kstep, voffB); PG8_STAGE(PG8_SA(1, 0), cA + kstep, voffA); PG8_STAGE(PG8_SB(1, 1), cB + hstep + kstep, voffB);
        PG8_WAIT_V(6); PG8_BAR;
    }
    for (;;) {
        const bool has_next = S.next(ui + 1, nxt);
        const char* nA = has_next ? (const char*)g.A + (size_t)nxt.pm * tstep : cA; const char* nB = has_next ? (const char*)g.Bt + (size_t)nxt.pn * tstep : cB;
        for (int t = 0; t < nt; t += 2) {
            const bool last = (t == nt - 2);
            const char* a1 = cA + (size_t)(t + 1) * kstep;
            const char* a2 = last ? nA : cA + (size_t)(t + 2) * kstep; const char* b2 = last ? nB : cB + (size_t)(t + 2) * kstep;
            const char* a3 = a2 + kstep; const char* b3 = b2 + kstep;
            if (last && has_next) S.a_ready(nxt);
            if constexpr (SP2) {
            PG8_LDB(B0, 0, 0); PG8_LDB(B1, 0, 1); PG8_SCHED; PG8_LDA(At, 0, 0); PG8_STAGE(PG8_SA(1, 1), a1 + hstep, voffA);
            PG8_WAIT_V(8); PG8_WAIT_L(0); PG8_BAR; PG8_MMA(0, 0, At, B0); PG8_MMA(0, 1, At, B1); PG8_BAR; PG8_SCHED;
            PG8_LDA(At, 0, 1); PG8_STAGE(PG8_SB(0, 0), b2, voffB); PG8_STAGE(PG8_SB(0, 1), b2 + hstep, voffB); PG8_STAGE(PG8_SA(0, 0), a2, voffA);
            PG8_WAIT_V(8); PG8_WAIT_L(0); PG8_BAR; PG8_MMA(1, 0, At, B0); PG8_MMA(1, 1, At, B1); PG8_BAR; PG8_SCHED;
            PG8_LDB(B0, 1, 0); PG8_LDB(B1, 1, 1); PG8_SCHED; PG8_LDA(At, 1, 0); PG8_STAGE(PG8_SA(0, 1), a2 + hstep, voffA);
            PG8_WAIT_V(8); PG8_WAIT_L(0); PG8_BAR; PG8_MMA(0, 0, At, B0); PG8_MMA(0, 1, At, B1); PG8_BAR; PG8_SCHED;
            PG8_LDA(At, 1, 1); PG8_STAGE(PG8_SB(1, 0), b3, voffB); PG8_STAGE(PG8_SB(1, 1), b3 + hstep, voffB); PG8_STAGE(PG8_SA(1, 0), a3, voffA);
            PG8_WAIT_V(8); PG8_WAIT_L(0); PG8_BAR; PG8_MMA(1, 0, At, B0); PG8_MMA(1, 1, At, B1); PG8_BAR; PG8_SCHED;
            } else {
            PG8_LDB(B0, 0, 0); PG8_SCHED; PG8_LDA(At, 0, 0); PG8_STAGE(PG8_SA(1, 1), a1 + hstep, voffA);
            PG8_WAIT_L(8); PG8_BAR; PG8_WAIT_L(0); PG8_MMA(0, 0, At, B0); PG8_BAR; PG8_SCHED;
            PG8_LDB(B1, 0, 1); PG8_STAGE(PG8_SB(0, 0), b2, voffB);
            PG8_BAR; PG8_WAIT_L(0); PG8_MMA(0, 1, At, B1); PG8_BAR;
            PG8_LDA(At, 0, 1); PG8_STAGE(PG8_SA(0, 0), a2, voffA);
            PG8_BAR; PG8_WAIT_L(0); PG8_MMA(1, 0, At, B0); PG8_BAR; PG8_SCHED;
            PG8_STAGE(PG8_SB(0, 1), b2 + hstep, voffB);
            PG8_WAIT_V(6); PG8_BAR; PG8_MMA(1, 1, At, B1); PG8_BAR;
            PG8_LDB(B0, 1, 0); PG8_SCHED; PG8_LDA(At, 1, 0); PG8_STAGE(PG8_SA(0, 1), a2 + hstep, voffA);
            PG8_WAIT_L(8); PG8_BAR; PG8_WAIT_L(0); PG8_MMA(0, 0, At, B0); PG8_BAR; PG8_SCHED;
            PG8_LDB(B1, 1, 1); PG8_STAGE(PG8_SB(1, 0), b3, voffB);
            PG8_BAR; PG8_WAIT_L(0); PG8_MMA(0, 1, At, B1); PG8_BAR;
            PG8_LDA(At, 1, 1); PG8_STAGE(PG8_SA(1, 0), a3, voffA);
            PG8_BAR; PG8_WAIT_L(0); PG8_MMA(1, 0, At, B0); PG8_BAR; PG8_SCHED;
            PG8_STAGE(PG8_SB(1, 1), b3 + hstep, voffB);
            PG8_WAIT_V(6); PG8_BAR; PG8_MMA(1, 1, At, B1); PG8_BAR;
            }
        }
        if constexpr (ALIGN_EPI) { if (wr == 0) PG8_BAR; }
        if constexpr (!Epi::AFTER_DRAIN) { E(acc, cur, wr, wc, fr, fq); S.done(cur); }
        if (!has_next) break;
#pragma unroll
        for (int a = 0; a < 2; ++a)
#pragma unroll
            for (int b = 0; b < 2; ++b)
#pragma unroll
                for (int m = 0; m < 4; ++m)
#pragma unroll
                    for (int n = 0; n < 2; ++n) acc[a][b][m][n] = (f32x4){0.f, 0.f, 0.f, 0.f};
        cur = nxt; cA = nA; cB = nB; ++ui;
        if constexpr (ALIGN_EPI) { if (wr == 1) PG8_BAR; }
    }
    PG8_WAIT_V(0);
    if constexpr (!ALIGN_EPI) { if (wr == 0) PG8_BAR; }
    PG8_BAR;
    if constexpr (Epi::AFTER_DRAIN) { E.fused(acc, cur, wr, wc, fr, fq, lds, wid, lane); S.done(cur); }
#undef PG8_SA
#undef PG8_SB
#undef PG8_STAGE
#undef PG8_LDA
#undef PG8_LDB
#undef PG8_MMA
#undef PG8_WAIT_V
#undef PG8_WAIT_L
#undef PG8_BAR
#undef PG8_SCHED
}
}
using pg8::bf16_t; using pg8::bf16x8; using pg8::f32x4; using pg8::u32x4; using pg8::u32x2; using pg8::cvt_pk_bf16; using pg8::bf2f;
#define LAS __attribute__((address_space(3)))
typedef float f32x16 __attribute__((ext_vector_type(16)));
typedef short s16x4 __attribute__((ext_vector_type(4)));

constexpr int DM = 1024, MP = 16384, MS = 512, MALL = MP + MS, DFF = 2816, NGU = 2 * DFF, ZP = 5376, PAST = 2048, KCROWS = 2112;
constexpr int QA_OFF = 0, KA_OFF = 512, VA_OFF = 1024, QB_OFF = 1536, KB_OFF = 1792, VB_OFF = 2048, RB_OFF = 2560, GA_OFF = 3072, GB_OFF = 4096, ALR_OFF = 5120;
constexpr int NCHUNK = 256;
constexpr int OP = 512;
constexpr size_t O_Y = 0, O_KP = (size_t)MALL * DM, O_VP = O_KP + 2ull * MP * 512, O_SP = O_VP + 2ull * MP * 512, O_KS = O_SP + 2ull * 4 * 64 * 128,
                 O_VS = O_KS + 2ull * MS * 512, O_SS = O_VS + 2ull * MS * 512, O_END = O_SS + 2ull * 32 * 4 * 64 * 128;
constexpr size_t al256(size_t x) { return (x + 255) & ~(size_t)255; }
constexpr size_t W_CTR = 0;
constexpr size_t W_WGU = 65536;
constexpr size_t W_WD = W_WGU + 4ull * NGU * DM * 2;
constexpr size_t W_WIN = W_WD + 4ull * DM * DFF * 2;
constexpr size_t W_WOA = W_WIN + 2ull * ZP * DM * 2;
constexpr size_t W_WOB = W_WOA + 2ull * DM * 512 * 2;
constexpr size_t W_WO = W_WOB + 2ull * DM * 512 * 2;
constexpr size_t W_H = W_WO + 2ull * DM * DM * 2;
constexpr size_t W_ACT = W_H + (size_t)MALL * DM * 2;
constexpr size_t W_Y = W_ACT + (size_t)MALL * DFF * 2;
constexpr size_t W_Z = W_Y + (size_t)MALL * DM * 2;
constexpr size_t W_OAB = W_Z + (size_t)MALL * ZP * 2;
constexpr size_t W_MIX = W_OAB + (size_t)MALL * DM * 2;
constexpr size_t W_KC = W_MIX + (size_t)MALL * DM * 2;
constexpr size_t W_VC = W_KC + 2ull * 32 * KCROWS * 512 * 2;
constexpr size_t W_DS = W_VC + 2ull * 32 * KCROWS * 512 * 2;
constexpr size_t W_DEC = W_DS + (size_t)NCHUNK * 4 * 64 * 128 * 4;
constexpr size_t W_ROPE = W_DEC + (size_t)NCHUNK * 4 * 64 * 4;
constexpr size_t W_END = W_ROPE + 2ull * MP * 32 * 4;

constexpr int LDS_MAIN = 131072, LDS_TOTAL = LDS_MAIN + 1024;

struct Params {
    const float *x_prompt, *x_sample, *cache_k, *cache_v, *state_gla, *norm_g, *w_gate, *w_up, *w_down, *w_in, *w_gate_up, *b_gate, *lambda_p, *subln_g, *gla_norm_g, *w_out_a, *w_out_b, *w_out;
    float* out; unsigned char* ws;
    float inv_freq[32];
};

__device__ __forceinline__ float wave_sum(float v) {
#pragma unroll
    for (int o = 1; o < 64; o <<= 1) v += __shfl_xor(v, o);
    return v;
}
__device__ __forceinline__ float swap32_add(float v) { auto rr = __builtin_amdgcn_permlane32_swap(__float_as_uint(v), __float_as_uint(v), false, false); return __uint_as_float(rr[0]) + __uint_as_float(rr[1]); }
__device__ __forceinline__ float swap32_max(float v) { auto rr = __builtin_amdgcn_permlane32_swap(__float_as_uint(v), __float_as_uint(v), false, false); return fmaxf(__uint_as_float(rr[0]), __uint_as_float(rr[1])); }
__device__ __forceinline__ float max3f(float a, float b, float c) { float r; asm("v_max3_f32 %0, %1, %2, %3" : "=v"(r) : "v"(a), "v"(b), "v"(c)); return r; }
__device__ __forceinline__ float fadd_s(float a, float b) { float r; asm("v_add_f32_e32 %0, %1, %2" : "=v"(r) : "v"(a), "v"(b)); return r; }
__device__ __forceinline__ int crow(int r, int hi) { return (r & 3) + 8 * (r >> 2) + 4 * hi; }
__device__ __forceinline__ unsigned f2bf(float f) { unsigned u = __float_as_uint(f); return (u + 0x7fffu + ((u >> 16) & 1u)) >> 16; }

__device__ __forceinline__ const float* tr_src(const float* W0, const float* W1, int mode, int np) {
    if (mode == 0) return W0 + np;
    if (mode == 1) { const int r = np & 255, pn = np >> 8; return (r < 128 ? W0 : W1) + 128 * pn + (r & 127); }
    if (np < 1024) { const int j = np & 63; return W0 + (np & ~63) + (j >> 1) + 32 * (j & 1); }
    if (np < 3072) return W0 + np;
    if (np < 5120) return W0 + np + 16;
    if (np < 5136) return W0 + 3072 + (np - 5120);
    return nullptr;
}
__device__ __forceinline__ void transpose_item(const float* W0, const float* W1, int Nsrc, int K, int mode, bf16_t* WT, LAS float* scr, int item, int nblk, int lane) {
    const int kb = item / nblk, nb = item % nblk, k0 = 64 * kb, n0 = 32 * nb;
    if (mode == 2 && n0 < 1024) {
        const float* src = tr_src(W0, W1, mode, n0 + (lane & 31));
#pragma unroll 8
        for (int i = 0; i < 32; ++i) { const int kk = 2 * i + (lane >> 5); scr[kk * 33 + (lane & 31)] = src[(size_t)(k0 + kk) * Nsrc]; }
    } else {
        const int n4 = 4 * (lane & 7); const float* src = tr_src(W0, W1, mode, n0 + n4);
#pragma unroll
        for (int i = 0; i < 8; ++i) { const int kk = 8 * i + (lane >> 3); f32x4 v = {0.f, 0.f, 0.f, 0.f}; if (src) v = *(const GAS f32x4*)(src + (size_t)(k0 + kk) * Nsrc);
            LAS float* d = scr + kk * 33 + n4; d[0] = v[0]; d[1] = v[1]; d[2] = v[2]; d[3] = v[3]; }
    }
    asm volatile("s_waitcnt lgkmcnt(0)" ::: "memory");
    const int c = lane & 7;
#pragma unroll
    for (int j = 0; j < 4; ++j) { const int n = (lane >> 3) + 8 * j; const LAS float* s = scr + (8 * c) * 33 + n;
        u32x4 o; o.x = cvt_pk_bf16(s[0 * 33], s[1 * 33]); o.y = cvt_pk_bf16(s[2 * 33], s[3 * 33]); o.z = cvt_pk_bf16(s[4 * 33], s[5 * 33]); o.w = cvt_pk_bf16(s[6 * 33], s[7 * 33]);
        *(GAS u32x4*)(WT + (size_t)(n0 + n) * K + k0 + 8 * c) = o; }
    asm volatile("s_waitcnt lgkmcnt(0)" ::: "memory");
}

template <int MODE> __device__ __forceinline__ void gemm_small(LAS unsigned char* lds, const bf16_t* A0, const bf16_t* B0, int K0, const bf16_t* A1, const bf16_t* B1, int K1, bf16_t* O, int ldo, const bf16_t* Zs) {
    int tid_ = threadIdx.x; asm volatile("" : "+v"(tid_));
    const int tid = tid_, lane = tid & 63, wid = __builtin_amdgcn_readfirstlane(tid >> 6), r32 = lane & 31, hi = lane >> 5;
    constexpr int NP = MODE == 1 ? 2 : 1;
    LAS float* R = (LAS float*)lds;
    for (int u = blockIdx.x; u < 256; u += gridDim.x) { const int um = u >> 4, un = u & 15;
        f32x16 acc[NP][2];
#pragma unroll
        for (int p = 0; p < NP; ++p)
#pragma unroll
            for (int cb = 0; cb < 2; ++cb)
#pragma unroll
                for (int r = 0; r < 16; ++r) acc[p][cb][r] = 0.f;
#pragma unroll
        for (int p = 0; p < NP; ++p) { const bf16_t* A = p ? A1 : A0; const bf16_t* B = p ? B1 : B0; const int K = p ? K1 : K0;
            const bf16_t* ap = A + (size_t)(32 * um + r32) * K + 8 * hi; const bf16_t* bp0 = B + (size_t)(64 * un + r32) * K + 8 * hi; const bf16_t* bp1 = bp0 + (size_t)32 * K;
            const int nks = K >> 4, per = nks >> 3, kb0 = wid * per;
            for (int ks = 0; ks < per; ks += 4) { bf16x8 a[4], b0[4], b1[4];
#pragma unroll
                for (int j = 0; j < 4; ++j) { const int kk = ks + j; const int kc = kb0 + ((kk < per) ? kk : 0);
                    a[j] = *(const GAS bf16x8*)(ap + 16 * kc); b0[j] = *(const GAS bf16x8*)(bp0 + 16 * kc); b1[j] = *(const GAS bf16x8*)(bp1 + 16 * kc); }
#pragma unroll
                for (int j = 0; j < 4; ++j) if (ks + j < per) {
                    acc[p][0] = __builtin_amdgcn_mfma_f32_32x32x16_bf16(a[j], b0[j], acc[p][0], 0, 0, 0); acc[p][1] = __builtin_amdgcn_mfma_f32_32x32x16_bf16(a[j], b1[j], acc[p][1], 0, 0, 0); } } }
#pragma unroll
        for (int p = 0; p < NP; ++p)
#pragma unroll
            for (int cb = 0; cb < 2; ++cb)
#pragma unroll
                for (int r = 0; r < 16; ++r) R[(((wid * NP + p) * 2 + cb) * 16 + r) * 64 + lane] = acc[p][cb][r];
        __syncthreads();
#pragma unroll
        for (int j = 0; j < 4; ++j) { const int idx = tid + 512 * j, cb = idx >> 10, r = (idx >> 6) & 15, ln = idx & 63; float v[NP];
#pragma unroll
            for (int p = 0; p < NP; ++p) { float s = 0.f;
#pragma unroll
                for (int w = 0; w < 8; ++w) s += R[(((w * NP + p) * 2 + cb) * 16 + r) * 64 + ln];
                v[p] = s; }
            const int row = 32 * um + crow(r, ln >> 5), col = 64 * un + 32 * cb + (ln & 31); float o = v[0];
            if (MODE == 1) { const GAS bf16_t* Zsg = (const GAS bf16_t*)Zs; const float ga = bf2f(Zsg[(size_t)row * ZP + GA_OFF + col]), gb = bf2f(Zsg[(size_t)row * ZP + GB_OFF + col]); o = pg8::fast_sigmoid(ga) * v[0] + pg8::fast_sigmoid(gb) * v[NP - 1]; }
            ((GAS bf16_t*)O)[(size_t)row * ldo + col] = (bf16_t)f2bf(o); }
        __syncthreads();
    }
}

__device__ __forceinline__ void rownorm_phase(const float* xinP, const float* xinS, float* xout, const bf16_t* Y, const float* ga, float cy, const float* gb, bf16_t* H, int gw, int NGW, int lane) {
    for (int m0 = gw; m0 < MALL; m0 += 2 * NGW) {
        int mr[2]; mr[0] = m0; mr[1] = (m0 + NGW < MALL) ? m0 + NGW : m0;
        f32x4 v[2][4]; u32x2 yw[2][4];
#pragma unroll
        for (int u = 0; u < 2; ++u) { const int m = mr[u]; const float* xr = (m < MP) ? xinP + (size_t)m * DM : xinS + (size_t)(m - MP) * DM;
#pragma unroll
            for (int j = 0; j < 4; ++j) v[u][j] = *(const GAS f32x4*)(xr + 4 * lane + 256 * j);
            if (Y) {
#pragma unroll
                for (int j = 0; j < 4; ++j) yw[u][j] = *(const GAS u32x2*)(Y + (size_t)m * DM + 4 * lane + 256 * j); } }
#pragma unroll
        for (int u = 0; u < 2; ++u) { const int m = mr[u];
            if (Y) {
                f32x4 y[4]; float s = 0.f;
#pragma unroll
                for (int j = 0; j < 4; ++j) { const u32x2 w = yw[u][j];
                    y[j][0] = __uint_as_float(w.x << 16); y[j][1] = __uint_as_float(w.x & 0xffff0000u); y[j][2] = __uint_as_float(w.y << 16); y[j][3] = __uint_as_float(w.y & 0xffff0000u);
                    s += (y[j][0] * y[j][0] + y[j][1] * y[j][1]) + (y[j][2] * y[j][2] + y[j][3] * y[j][3]); }
                const float rstd = cy * __builtin_amdgcn_rsqf(wave_sum(s) * (1.f / DM) + 1e-6f);
#pragma unroll
                for (int j = 0; j < 4; ++j) { const f32x4 g = *(const GAS f32x4*)(ga + 4 * lane + 256 * j); v[u][j] = v[u][j] + y[j] * g * rstd; }
            }
#pragma unroll
            for (int j = 0; j < 4; ++j) *(GAS f32x4*)(xout + (size_t)m * DM + 4 * lane + 256 * j) = v[u][j];
            if (H) {
                float s = 0.f;
#pragma unroll
                for (int j = 0; j < 4; ++j) s += (v[u][j][0] * v[u][j][0] + v[u][j][1] * v[u][j][1]) + (v[u][j][2] * v[u][j][2] + v[u][j][3] * v[u][j][3]);
                const float rstd = __builtin_amdgcn_rsqf(wave_sum(s) * (1.f / DM) + 1e-6f);
#pragma unroll
                for (int j = 0; j < 4; ++j) { const f32x4 g = *(const GAS f32x4*)(gb + 4 * lane + 256 * j); const f32x4 o = v[u][j] * g * rstd;
                    u32x2 w; w.x = cvt_pk_bf16(o[0], o[1]); w.y = cvt_pk_bf16(o[2], o[3]); *(GAS u32x2*)(H + (size_t)m * DM + 4 * lane + 256 * j) = w; }
            }
        }
    }
}

__device__ __forceinline__ void attn_unit(LAS unsigned char* lds, const bf16_t* Qp, int q_pitch, int q_clamp, const bf16_t* Kp, const bf16_t* Vp, int kv_pitch, const float* Kf, const float* Vf, int NT, int last_valid,
                                          int sample, int q0, bf16_t* Op, int out_rows, float lam, const float* subg, float oscale) {
    int tid_ = threadIdx.x; asm volatile("" : "+v"(tid_));
    const int tid = tid_, lane = tid & 63, wid = __builtin_amdgcn_readfirstlane(tid >> 6), s = wid & 1, rg = wid >> 1, r32 = lane & 31, hi = lane >> 5;
    const int nt_w = sample ? (rg == 0 ? NT : 0) : (((q0 + 32 * rg) >> 6) + 1);
    bf16x8 qf[4];
    { int qrow = 32 * rg + r32; qrow = qrow < q_clamp ? qrow : q_clamp;
#pragma unroll
      for (int d0 = 0; d0 < 4; ++d0) qf[d0] = *(const GAS bf16x8*)(Qp + (size_t)qrow * q_pitch + 64 * s + 16 * d0 + 8 * hi); }
    const int key0 = tid >> 4, ch = tid & 15;
    const bf16_t* kg = Kp + (size_t)key0 * kv_pitch + ch * 8; const bf16_t* vg = Vp + (size_t)key0 * kv_pitch + ch * 8;
    const size_t g32 = (size_t)32 * kv_pitch, gtile = (size_t)64 * kv_pitch;
    const int kl0 = (ch >> 3) * 8192 + key0 * 128 + (((ch & 7) ^ ((key0 >> 1) & 7)) << 4), kl1 = kl0 + 32 * 128;
    const int vl0 = 16384 + 256 * key0 + 16 * (ch ^ (((key0 & 3) << 2) | ((key0 >> 2) & 3))), vl1 = vl0 + 8192;
    u32x4 ra[4], rb[4];
#define ATT_LOAD(R, T) do { const bf16_t* kgn_ = kg + (size_t)(T) * gtile; const bf16_t* vgn_ = vg + (size_t)(T) * gtile; \
        R[0] = *(const GAS u32x4*)kgn_; R[1] = *(const GAS u32x4*)(kgn_ + g32); R[2] = *(const GAS u32x4*)vgn_; R[3] = *(const GAS u32x4*)(vgn_ + g32); } while (0)
#define ATT_STORE(R, BUF) do { LAS unsigned char* nb_ = lds + (BUF) * 32768; *(LAS u32x4*)(nb_ + kl0) = R[0]; *(LAS u32x4*)(nb_ + kl1) = R[1]; *(LAS u32x4*)(nb_ + vl0) = R[2]; *(LAS u32x4*)(nb_ + vl1) = R[3]; } while (0)
    const int kfo = s * 8192 + r32 * 128;
    const int q4 = (lane & 15) >> 2, g1 = (lane >> 4) & 1, p = lane & 3, c2 = 2 * g1 + (p >> 1);
    const int vbase = 16384 + 256 * (4 * hi + q4) + 8 * (p & 1);
    int cx[2]; const int q464 = 64 * q4;
#pragma unroll
    for (int j = 0; j < 2; ++j) cx[j] = 16 * (c2 ^ (hi + 2 * j)) + 2048 * j;
    f32x16 o[4];
#pragma unroll
    for (int eb = 0; eb < 4; ++eb)
#pragma unroll
        for (int r = 0; r < 16; ++r) o[eb][r] = 0.f;
    float lrun = 0.f;
    f32x16 negm;
#pragma unroll
    for (int r = 0; r < 16; ++r) negm[r] = 0.f;
#define ATT_VRD(KS) do { _Pragma("unroll") for (int eb = 0; eb < 4; ++eb) { \
        vv[2 * eb] = __builtin_bit_cast(s16x4, __builtin_amdgcn_ds_read_tr16_b64_v4i16((LAS s16x4*)(base + vbase + 4096 * (KS) + cx[0] + ((64 * eb) ^ q464)))); \
        vv[2 * eb + 1] = __builtin_bit_cast(s16x4, __builtin_amdgcn_ds_read_tr16_b64_v4i16((LAS s16x4*)(base + vbase + 4096 * (KS) + cx[1] + ((64 * eb) ^ q464)))); } } while (0)
#define ATT_COMPUTE(t) do { \
        if (t < nt_w) { \
            const LAS unsigned char* base = lds + (t & 1) * 32768; \
            f32x16 sA, sB; \
            { const LAS unsigned char* kb_ = base + kfo; bf16x8 kfa_[4], kfb_[4]; \
              _Pragma("unroll") for (int d0 = 0; d0 < 4; ++d0) { const int co = (((2 * d0 + hi) ^ ((r32 >> 1) & 7)) << 4); kfa_[d0] = *(const LAS bf16x8*)(kb_ + co); kfb_[d0] = *(const LAS bf16x8*)(kb_ + 4096 + co); } \
              __builtin_amdgcn_sched_barrier(0); \
              sA = __builtin_amdgcn_mfma_f32_32x32x16_bf16(kfa_[0], qf[0], negm, 0, 0, 0); sB = __builtin_amdgcn_mfma_f32_32x32x16_bf16(kfb_[0], qf[0], negm, 0, 0, 0); \
              _Pragma("unroll") for (int d0 = 1; d0 < 4; ++d0) { sA = __builtin_amdgcn_mfma_f32_32x32x16_bf16(kfa_[d0], qf[d0], sA, 0, 0, 0); sB = __builtin_amdgcn_mfma_f32_32x32x16_bf16(kfb_[d0], qf[d0], sB, 0, 0, 0); } \
              __builtin_amdgcn_sched_barrier(0); } \
            if (t == NT - 1 && last_valid < 64) { \
                _Pragma("unroll") for (int r = 0; r < 16; ++r) { const int kv = crow(r, hi); if (kv >= last_valid) sA[r] = -INFINITY; if (kv + 32 >= last_valid) sB[r] = -INFINITY; } } \
            asm volatile("s_nop 15\n\ts_nop 7" : "+v"(sA), "+v"(sB));     \
            float rm; { float a_ = max3f(sA[0], sA[1], sB[0]), b_ = max3f(sA[2], sA[3], sB[1]); a_ = max3f(a_, sB[2], sB[3]); \
              _Pragma("unroll") for (int r = 4; r < 16; r += 4) { a_ = max3f(a_, sA[r], sA[r + 1]); b_ = max3f(b_, sA[r + 2], sA[r + 3]); a_ = max3f(a_, sB[r], sB[r + 1]); b_ = max3f(b_, sB[r + 2], sB[r + 3]); } \
              rm = fmaxf(a_, b_); } \
            rm = swap32_max(rm); \
            if (t == 0 || __any(rm > 8.0f)) { const float dl = (t == 0) ? rm : fmaxf(rm, 0.f); const float f = __builtin_amdgcn_exp2f(-dl); const float nm = negm[0] - dl; lrun *= f; \
                _Pragma("unroll") for (int eb = 0; eb < 4; ++eb) _Pragma("unroll") for (int r = 0; r < 16; ++r) o[eb][r] *= f; \
                _Pragma("unroll") for (int r = 0; r < 16; ++r) { sA[r] -= dl; sB[r] -= dl; negm[r] = nm; } } \
            _Pragma("unroll") for (int r = 0; r < 16; ++r) { sA[r] = __builtin_amdgcn_exp2f(sA[r]); sB[r] = __builtin_amdgcn_exp2f(sB[r]); } \
            asm volatile("s_nop 1" : "+v"(sA), "+v"(sB));     \
            { float l0_ = sA[0], l1_ = sB[0];     \
              _Pragma("unroll") for (int r = 1; r < 16; ++r) { l0_ = fadd_s(l0_, sA[r]); l1_ = fadd_s(l1_, sB[r]); } \
              lrun += fadd_s(l0_, l1_); } \
            u32x4 pw[4]; \
            _Pragma("unroll") for (int i = 0; i < 4; ++i) { pw[0][i] = cvt_pk_bf16(sA[2 * i], sA[2 * i + 1]); pw[1][i] = cvt_pk_bf16(sA[8 + 2 * i], sA[9 + 2 * i]); pw[2][i] = cvt_pk_bf16(sB[2 * i], sB[2 * i + 1]); pw[3][i] = cvt_pk_bf16(sB[8 + 2 * i], sB[9 + 2 * i]); } \
            s16x4 vv[8]; \
            _Pragma("unroll") for (int ks = 0; ks < 4; ++ks) { const bf16x8 pf = __builtin_bit_cast(bf16x8, pw[ks]); \
                ATT_VRD(ks); \
                __builtin_amdgcn_sched_barrier(0); \
                _Pragma("unroll") for (int eb = 0; eb < 4; ++eb) { const s16x4 lo = vv[2 * eb], hh = vv[2 * eb + 1]; \
                    const bf16x8 vf = {lo[0], lo[1], lo[2], lo[3], hh[0], hh[1], hh[2], hh[3]}; \
                    o[eb] = __builtin_amdgcn_mfma_f32_32x32x16_bf16(vf, pf, o[eb], 0, 0, 0); } \
                __builtin_amdgcn_sched_barrier(0); } \
        } \
        } while (0)
#define ATT_STEP(RW, RN, T) do { const int t_ = (T); \
        if (t_ + 2 < NT) ATT_LOAD(RN, t_ + 2); \
        ATT_COMPUTE(t_); \
        if (t_ + 1 < NT) ATT_STORE(RW, (t_ + 1) & 1); \
        __syncthreads(); } while (0)
    if (!sample) {
        ATT_LOAD(ra, 0);
        if (NT > 1) ATT_LOAD(rb, 1);
        ATT_STORE(ra, 0);
        __syncthreads();
        int tt = 0;
        for (; tt + 1 < NT; tt += 2) { ATT_STEP(rb, ra, tt); ATT_STEP(ra, rb, tt + 1); }
        if (tt < NT) ATT_STEP(rb, ra, tt);
    } else {
        const float* kfp = Kf + (size_t)key0 * 512 + ch * 8; const float* vfp = Vf + (size_t)key0 * 512 + ch * 8;
#define ATT_LOADF(T) do { const float* kfn_ = kfp + (size_t)(T) * 32768; const float* vfn_ = vfp + (size_t)(T) * 32768; \
            ra[0] = *(const GAS u32x4*)kfn_; ra[1] = *(const GAS u32x4*)(kfn_ + 4); ra[2] = *(const GAS u32x4*)(kfn_ + 16384); ra[3] = *(const GAS u32x4*)(kfn_ + 16388); \
            rb[0] = *(const GAS u32x4*)vfn_; rb[1] = *(const GAS u32x4*)(vfn_ + 4); rb[2] = *(const GAS u32x4*)(vfn_ + 16384); rb[3] = *(const GAS u32x4*)(vfn_ + 16388); } while (0)
#define ATT_F4(x) __builtin_bit_cast(f32x4, x)
#define ATT_STOREF(BUF) do { LAS unsigned char* nb_ = lds + (BUF) * 32768; \
            *(LAS u32x4*)(nb_ + kl0) = pg8::pack8(ATT_F4(ra[0]), ATT_F4(ra[1])); *(LAS u32x4*)(nb_ + kl1) = pg8::pack8(ATT_F4(ra[2]), ATT_F4(ra[3])); \
            *(LAS u32x4*)(nb_ + vl0) = pg8::pack8(ATT_F4(rb[0]), ATT_F4(rb[1])); *(LAS u32x4*)(nb_ + vl1) = pg8::pack8(ATT_F4(rb[2]), ATT_F4(rb[3])); } while (0)
        ATT_LOADF(0); ATT_STOREF(0);
        __syncthreads();
        for (int ts = 0; ts < NT; ++ts) {
            if (ts + 2 < NT) ATT_LOADF(ts + 1); else if (ts + 1 < NT) ATT_LOAD(ra, ts + 1);
            ATT_COMPUTE(ts);
            if (ts + 2 < NT) ATT_STOREF((ts + 1) & 1); else if (ts + 1 < NT) ATT_STORE(ra, (ts + 1) & 1);
            __syncthreads();
        }
#undef ATT_LOADF
#undef ATT_F4
#undef ATT_STOREF
    }
#undef ATT_COMPUTE
#undef ATT_LOAD
#undef ATT_STORE
#undef ATT_VRD
#undef ATT_STEP
    const float lt = swap32_add(lrun); const float inv = __builtin_amdgcn_rcpf(lt);
    LAS float* X = (LAS float*)(lds + 65536 + rg * 16384);
    if (s == 1 && nt_w > 0) {
#pragma unroll
        for (int eb = 0; eb < 4; ++eb)
#pragma unroll
            for (int r = 0; r < 16; ++r) X[(eb * 16 + r) * 64 + lane] = o[eb][r] * inv;
    }
    __syncthreads();
    if (s == 0 && nt_w > 0) {
        float ss = 0.f;
#pragma unroll
        for (int eb = 0; eb < 4; ++eb)
#pragma unroll
            for (int r = 0; r < 16; ++r) { const float v = o[eb][r] * inv - lam * X[(eb * 16 + r) * 64 + lane]; o[eb][r] = v; ss += v * v; }
        ss = swap32_add(ss);
        const float rstd = __builtin_amdgcn_rsqf(ss * (1.f / 128.f) + 1e-5f) * oscale;
        const int row = 32 * rg + r32;
        if (row < out_rows) {
#pragma unroll
            for (int eb = 0; eb < 4; ++eb)
#pragma unroll
                for (int g4 = 0; g4 < 4; ++g4) { const int e = 32 * eb + 8 * g4 + 4 * hi; const f32x4 g = *(const GAS f32x4*)(subg + e);
                    u32x2 w; w.x = cvt_pk_bf16(o[eb][4 * g4] * rstd * g[0], o[eb][4 * g4 + 1] * rstd * g[1]); w.y = cvt_pk_bf16(o[eb][4 * g4 + 2] * rstd * g[2], o[eb][4 * g4 + 3] * rstd * g[3]);
                    *(GAS u32x2*)(Op + (size_t)row * OP + e) = w; }
        }
    }
    __syncthreads();
}

constexpr int G_LA = 0, G_ALR = 16640, G_WG = G_ALR + 4096, G_BG = G_WG + 4096, G_SEG = G_BG + 256, G_KE = G_SEG + 2048, G_KDT = G_KE + 9216, G_QE = G_KDT + 9216, G_ATT = G_QE + 9216, G_VT = G_ATT + 9216, G_ST = G_VT + 18432, G_END = G_ST + 18432;
static_assert(G_KDT >= 64 * 132 * 4, "OBUF aliases LA..KE");
static_assert(G_END <= LDS_MAIN, "gla lds");
template <int MODE> __device__ __forceinline__ void gla_unit(LAS unsigned char* lds, const bf16_t* Zr, int ntok, const float* wgu, const float* bgp, int h, float* ds_out, float* dec_out,
                                                              const float* Sprev, float* sfin, const float* glang, bf16_t* Oout) {
    int tid_ = threadIdx.x; asm volatile("" : "+v"(tid_));
    const int tid = tid_, lane = tid & 63, wid = __builtin_amdgcn_readfirstlane(tid >> 6), r32 = lane & 31, hi = lane >> 5;
    const GAS bf16_t* Zg = (const GAS bf16_t*)Zr; const GAS float* wgu_g = (const GAS float*)wgu; const GAS float* bg_g = (const GAS float*)bgp; const GAS float* Sp_g = (const GAS float*)Sprev;
    GAS float* ds_g = (GAS float*)ds_out; GAS float* dec_g = (GAS float*)dec_out; GAS float* sf_g = (GAS float*)sfin; const GAS float* gl_g = (const GAS float*)glang;
    const int pt = tid >> 3, pd8 = (tid & 7) * 8, vt0 = tid >> 4, vc8 = (tid & 15) * 8;
    u32x4 qw = {0u, 0u, 0u, 0u}, kw = qw, vw0 = qw, vw1 = qw, rw0 = qw, rw1 = qw; f32x4 sw[4];
    if (pt < ntok) { qw = *(const GAS u32x4*)(Zg + (size_t)pt * ZP + QB_OFF + 64 * h + pd8); kw = *(const GAS u32x4*)(Zg + (size_t)pt * ZP + KB_OFF + 64 * h + pd8); }
    if (vt0 < ntok) vw0 = *(const GAS u32x4*)(Zg + (size_t)vt0 * ZP + VB_OFF + 128 * h + vc8);
    if (vt0 + 32 < ntok) vw1 = *(const GAS u32x4*)(Zg + (size_t)(vt0 + 32) * ZP + VB_OFF + 128 * h + vc8);
    if (MODE != 0) {
#pragma unroll
        for (int j = 0; j < 4; ++j) { const int idx = tid + 512 * j; sw[j] = *(const GAS f32x4*)(Sp_g + (idx >> 5) * 128 + (idx & 31) * 4); }
        if (pt < ntok) { const GAS bf16_t* rbp = Zg + (size_t)pt * ZP + RB_OFF + 128 * h + 16 * (tid & 7); rw0 = *(const GAS u32x4*)rbp; rw1 = *(const GAS u32x4*)(rbp + 8); }
    }
    LAS float* LA = (LAS float*)(lds + G_LA); LAS float* ALR = (LAS float*)(lds + G_ALR); LAS float* WG = (LAS float*)(lds + G_WG); LAS float* BG = (LAS float*)(lds + G_BG); LAS float* SEG = (LAS float*)(lds + G_SEG);
    LAS bf16_t* KE = (LAS bf16_t*)(lds + G_KE); LAS bf16_t* KDT = (LAS bf16_t*)(lds + G_KDT); LAS bf16_t* QE = (LAS bf16_t*)(lds + G_QE); LAS bf16_t* ATT = (LAS bf16_t*)(lds + G_ATT);
    LAS bf16_t* VT = (LAS bf16_t*)(lds + G_VT); LAS bf16_t* ST = (LAS bf16_t*)(lds + G_ST); LAS float* OB = (LAS float*)(lds + 0);
#pragma unroll
    for (int j = 0; j < 2; ++j) { const int e = tid + 512 * j, t = e >> 4, r = e & 15; ALR[e] = (t < ntok) ? bf2f(Zg[(size_t)t * ZP + ALR_OFF + r]) : 0.f;
        const int rr = e >> 6, d = e & 63; WG[e] = wgu_g[rr * 256 + 64 * h + d]; }
    if (tid < 64) BG[tid] = bg_g[64 * h + tid];
    __syncthreads();
#pragma unroll
    for (int j = 0; j < 8; ++j) { const int e = tid + 512 * j, t = e >> 6, d = e & 63; float x = BG[d];
#pragma unroll
        for (int r = 0; r < 16; ++r) x += ALR[t * 16 + r] * WG[r * 64 + d];
        const float ls = fminf(x, 0.f) - __logf(1.f + __expf(-fabsf(x)));
        LA[t * 65 + d] = (t < ntok) ? ls * (1.f / 16.f) : 0.f; }
    __syncthreads();
    { const int d = tid & 63, sg = tid >> 6; float run = 0.f;
#pragma unroll
      for (int i = 0; i < 8; ++i) { run += LA[(8 * sg + i) * 65 + d]; LA[(8 * sg + i) * 65 + d] = run; }
      SEG[sg * 64 + d] = run;
      __syncthreads();
      float pre = 0.f;
#pragma unroll
      for (int q = 0; q < 8; ++q) pre += (q < sg) ? SEG[q * 64 + d] : 0.f;
#pragma unroll
      for (int i = 0; i < 8; ++i) LA[(8 * sg + i) * 65 + d] += pre; }
    __syncthreads();
    { f32x4 q0, q1, k0, k1; pg8::unpack8(qw, q0, q1); pg8::unpack8(kw, k0, k1); f32x4 e0, e1, f0, f1;
#pragma unroll
      for (int i = 0; i < 8; ++i) { const int d = pd8 + i; const float b = LA[pt * 65 + d], bl = LA[63 * 65 + d]; const float q = (i < 4) ? q0[i & 3] : q1[i & 3], k = (i < 4) ? k0[i & 3] : k1[i & 3];
          const float qe = q * __expf(b), ke = k * __expf(-b); if (i < 4) { e0[i & 3] = qe; f0[i & 3] = ke; } else { e1[i & 3] = qe; f1[i & 3] = ke; }
          KDT[d * 72 + pt] = (bf16_t)f2bf(k * __expf(bl - b)); }
      *(LAS u32x4*)(QE + pt * 72 + pd8) = pg8::pack8(e0, e1); *(LAS u32x4*)(KE + pt * 72 + pd8) = pg8::pack8(f0, f1); }
#pragma unroll
    for (int i = 0; i < 4; ++i) { const unsigned a0 = vw0[i], a1 = vw1[i];
        VT[(vc8 + 2 * i) * 72 + vt0] = (bf16_t)(a0 & 0xffffu); VT[(vc8 + 2 * i + 1) * 72 + vt0] = (bf16_t)(a0 >> 16);
        VT[(vc8 + 2 * i) * 72 + vt0 + 32] = (bf16_t)(a1 & 0xffffu); VT[(vc8 + 2 * i + 1) * 72 + vt0 + 32] = (bf16_t)(a1 >> 16); }
    if (MODE != 0) {
#pragma unroll
        for (int j = 0; j < 4; ++j) { const int idx = tid + 512 * j, d = idx >> 5, c4 = (idx & 31) * 4;
#pragma unroll
            for (int i = 0; i < 4; ++i) ST[(c4 + i) * 72 + d] = (bf16_t)f2bf(sw[j][i]); }
    }
    if (MODE == 0 && tid < 64) dec_g[tid] = __expf(LA[63 * 65 + tid]);
    __syncthreads();
    if (MODE != 1) { const int mb = wid >> 2, nb = wid & 3; f32x16 acc;
#pragma unroll
        for (int r = 0; r < 16; ++r) acc[r] = 0.f;
#pragma unroll
        for (int ks = 0; ks < 4; ++ks) { const bf16x8 a = *(const LAS bf16x8*)(KDT + (32 * mb + r32) * 72 + 16 * ks + 8 * hi), b = *(const LAS bf16x8*)(VT + (32 * nb + r32) * 72 + 16 * ks + 8 * hi);
            acc = __builtin_amdgcn_mfma_f32_32x32x16_bf16(a, b, acc, 0, 0, 0); }
#pragma unroll
        for (int r = 0; r < 16; ++r) { const int d = 32 * mb + crow(r, hi), e = 32 * nb + r32;
            if (MODE == 0) ds_g[d * 128 + e] = acc[r];
            else sf_g[d * 128 + e] = __expf(LA[63 * 65 + d]) * Sp_g[d * 128 + e] + acc[r]; }
    }
    if (MODE != 0) {
        if (wid < 4) { const int ib = wid >> 1, jb = wid & 1; f32x16 acc;
#pragma unroll
            for (int r = 0; r < 16; ++r) acc[r] = 0.f;
#pragma unroll
            for (int ks = 0; ks < 4; ++ks) { const bf16x8 a = *(const LAS bf16x8*)(QE + (32 * ib + r32) * 72 + 16 * ks + 8 * hi), b = *(const LAS bf16x8*)(KE + (32 * jb + r32) * 72 + 16 * ks + 8 * hi);
                acc = __builtin_amdgcn_mfma_f32_32x32x16_bf16(a, b, acc, 0, 0, 0); }
#pragma unroll
            for (int r = 0; r < 16; ++r) { const int i = 32 * ib + crow(r, hi), jj = 32 * jb + r32; ATT[i * 72 + jj] = (bf16_t)f2bf(jj <= i ? acc[r] : 0.f); }
        }
        __syncthreads();
        { const int ib = wid >> 2, eb = wid & 3; f32x16 acc;
#pragma unroll
          for (int r = 0; r < 16; ++r) acc[r] = 0.f;
#pragma unroll
          for (int ks = 0; ks < 4; ++ks) { const bf16x8 a = *(const LAS bf16x8*)(ATT + (32 * ib + r32) * 72 + 16 * ks + 8 * hi), b = *(const LAS bf16x8*)(VT + (32 * eb + r32) * 72 + 16 * ks + 8 * hi);
              acc = __builtin_amdgcn_mfma_f32_32x32x16_bf16(a, b, acc, 0, 0, 0); }
#pragma unroll
          for (int ks = 0; ks < 4; ++ks) { const bf16x8 a = *(const LAS bf16x8*)(QE + (32 * ib + r32) * 72 + 16 * ks + 8 * hi), b = *(const LAS bf16x8*)(ST + (32 * eb + r32) * 72 + 16 * ks + 8 * hi);
              acc = __builtin_amdgcn_mfma_f32_32x32x16_bf16(a, b, acc, 0, 0, 0); }
#pragma unroll
          for (int r = 0; r < 16; ++r) OB[(32 * ib + crow(r, hi)) * 132 + 32 * eb + r32] = acc[r];
        }
        __syncthreads();
        { const int i = tid >> 3, sg = tid & 7; float v[16]; float ss = 0.f;
#pragma unroll
          for (int c = 0; c < 16; ++c) { v[c] = OB[i * 132 + 16 * sg + c]; ss += v[c] * v[c]; }
          ss += __shfl_xor(ss, 1); ss += __shfl_xor(ss, 2); ss += __shfl_xor(ss, 4);
          const float rstd = __builtin_amdgcn_rsqf(ss * (1.f / 128.f) + 1e-5f);
          if (i < ntok) {
#pragma unroll
              for (int hh = 0; hh < 2; ++hh) { const u32x4 rw = hh ? rw1 : rw0; f32x4 r0, r1; pg8::unpack8(rw, r0, r1); f32x4 o0, o1;
#pragma unroll
                  for (int c = 0; c < 4; ++c) { const float g0 = gl_g[16 * sg + 8 * hh + c], g1 = gl_g[16 * sg + 8 * hh + 4 + c];
                      o0[c] = v[8 * hh + c] * rstd * g0 * r0[c] * pg8::fast_sigmoid(r0[c]); o1[c] = v[8 * hh + 4 + c] * rstd * g1 * r1[c] * pg8::fast_sigmoid(r1[c]); }
                  *(GAS u32x4*)(Oout + (size_t)i * OP + 16 * sg + 8 * hh) = pg8::pack8(o0, o1); } }
        }
    }
    __syncthreads();
}

__device__ __forceinline__ unsigned char* opq(unsigned char* p) { asm volatile("" : "+s"(p)); return p; }
__device__ __forceinline__ float* opqf(float* p) { asm volatile("" : "+s"(p)); return p; }
#define XB_TMO      128
#define XB_XCNT(j)  (256  + 64 * (j))
#define XB_XSUB(j)  (1280 + 64 * (j))
#define XB_XGEN(j)  (2304 + 64 * (j))
#define XB_TOP      3328
#define XB_TOPGEN   3392
#define XCD_BAR_WORDS 3456
#define XB_SPIN_CAP (1u << 18)

__device__ __forceinline__ unsigned xb_ld(unsigned* p)              { return __hip_atomic_load(p, __ATOMIC_RELAXED, __HIP_MEMORY_SCOPE_AGENT); }
__device__ __forceinline__ unsigned xb_add(unsigned* p, unsigned v) { return __hip_atomic_fetch_add(p, v, __ATOMIC_RELAXED, __HIP_MEMORY_SCOPE_AGENT); }
__device__ __forceinline__ unsigned xb_xcc_id() { return (unsigned)__builtin_amdgcn_s_getreg((3 << 11) | 20) & 0xFu; }
#define XB_SPIN(cond, bar) do { unsigned _sp = 0; while (cond) { __builtin_amdgcn_s_sleep(1); \
    if ((++_sp & 255u) == 0u) { if (xb_ld(&(bar)[XB_TMO])) break; if (_sp > XB_SPIN_CAP) { atomicAdd(&(bar)[XB_TMO], 1u); break; } } } } while (0)

struct XcdBarrier {
    unsigned* bar; unsigned x;
    volatile LAS unsigned* st;
};

__device__ __forceinline__ XcdBarrier xcd_barrier_post(unsigned* bar, volatile LAS unsigned* st) {
    XcdBarrier b; b.bar = bar; b.x = xb_xcc_id(); b.st = st;
    if (threadIdx.x == 0) (void)xb_add(&bar[XB_XCNT(b.x)], 1u);
    return b;
}
__device__ __forceinline__ void xcd_barrier_complete(unsigned* bar, unsigned x, unsigned& nloc, unsigned& nx) {
    const unsigned G = gridDim.x * gridDim.y * gridDim.z;
    unsigned sum, cnt, mine, sp = 0u;
    for (;;) {
        sum = 0u; cnt = 0u; mine = 0u;
#pragma unroll
        for (unsigned j = 0; j < 16; ++j) { const unsigned c = xb_ld(&bar[XB_XCNT(j)]); sum += c; cnt += (c > 0u) ? 1u : 0u; mine = (j == x) ? c : mine; }
        if (sum == G) break;
        __builtin_amdgcn_s_sleep(1);
        if ((++sp & 255u) == 0u) { if (xb_ld(&bar[XB_TMO])) break; if (sp > XB_SPIN_CAP) { atomicAdd(&bar[XB_TMO], 1u); break; } }
    }
    nloc = mine > 0u ? mine : 1u; nx = cnt > 0u ? cnt : 1u;
}

__device__ __forceinline__ void xcd_barrier(const XcdBarrier& b) {
    asm volatile("s_waitcnt vmcnt(0)" ::: "memory");
    __syncthreads();
    if (threadIdx.x == 0) {
        unsigned* bar = b.bar;
        __builtin_amdgcn_s_waitcnt(0);
        unsigned nloc = b.st[0], nx = b.st[1];
        if (nloc == 0u) { xcd_barrier_complete(bar, b.x, nloc, nx); b.st[0] = nloc; b.st[1] = nx; }
        const unsigned old = xb_add(&bar[XB_XSUB(b.x)], 1u);
        const unsigned gen = old / nloc;
        if (old + 1u == (gen + 1u) * nloc) {
            __builtin_amdgcn_fence(__ATOMIC_RELEASE, "agent");
            asm volatile("s_waitcnt vmcnt(0)" ::: "memory");
            const unsigned og = xb_add(&bar[XB_TOP], 1u);
            const unsigned tg = og / nx;
            if (og + 1u == (tg + 1u) * nx) xb_add(&bar[XB_TOPGEN], 1u);
            else XB_SPIN(xb_ld(&bar[XB_TOPGEN]) == tg, bar);
            __builtin_amdgcn_fence(__ATOMIC_ACQUIRE, "agent");
            xb_add(&bar[XB_XGEN(b.x)], 1u);
            asm volatile("s_waitcnt vmcnt(0)" ::: "memory");
        } else {
            XB_SPIN(xb_ld(&bar[XB_XGEN(b.x)]) == gen, bar);
            __builtin_amdgcn_fence(__ATOMIC_ACQUIRE, "agent");
            asm volatile("s_waitcnt vmcnt(0)" ::: "memory");
        }
    }
    __syncthreads();
}

template <class Epi> __device__ __forceinline__ void run_gemm(LAS unsigned char* lds, const bf16_t* A, const bf16_t* Bt, int M, int N, int K, const Epi& E) {
    pg8::Gemm g{A, Bt, M, N, K}; pg8::StaticOrder S; S.init(M, N, (int)gridDim.x, (int)blockIdx.x);
    pg8::gemm_phase<Epi, pg8::StaticOrder, true, true>(lds, g, S, E);
}

constexpr float QSCALE = 0.125f * 1.4426950408889634f;

__global__ void __launch_bounds__(512, 2) mega_fwd(Params P) {
    extern __shared__ __attribute__((aligned(16))) unsigned char lds_raw[];
    LAS unsigned char* lds = (LAS unsigned char*)lds_raw;
    cg::grid_group grid = cg::this_grid();
    int tid = threadIdx.x; asm volatile("" : "+v"(tid)); int lane = tid & 63, wid = __builtin_amdgcn_readfirstlane(tid >> 6);
    const int G = gridDim.x, bid = blockIdx.x, NGW = G * 8; int gw = bid * 8 + wid;
    unsigned char* wsl = opq(P.ws); float* outl = opqf(P.out);
#define NEWPHASE() do { wsl = opq(P.ws); outl = opqf(P.out); tid = threadIdx.x; asm volatile("" : "+v"(tid)); lane = tid & 63; wid = __builtin_amdgcn_readfirstlane(tid >> 6); gw = bid * 8 + wid; } while (0)
#define WSB() wsl
#define GSYNC() do { XcdBarrier b_; b_.bar = (unsigned*)(opq(P.ws) + W_CTR) + 1024; b_.x = xb_xcc_id(); b_.st = (volatile LAS unsigned*)(misc + 8); xcd_barrier(b_); NEWPHASE(); } while (0)
#define PB(off) ((bf16_t*)(WSB() + (off)))
#define PF(off) ((float*)(WSB() + (off)))
#define ctr ((unsigned*)(WSB() + W_CTR))
#define WGU PB(W_WGU)
#define WD PB(W_WD)
#define WIN PB(W_WIN)
#define WOA PB(W_WOA)
#define WOB PB(W_WOB)
#define WO PB(W_WO)
#define H PB(W_H)
#define ACT PB(W_ACT)
#define Y PB(W_Y)
#define Z PB(W_Z)
#define OA PB(W_OAB)
#define OB (PB(W_OAB) + (size_t)MALL * OP)
#define MIX PB(W_MIX)
#define KC PB(W_KC)
#define VC PB(W_VC)
#define DS PF(W_DS)
#define DEC PF(W_DEC)
#define ropec PF(W_ROPE)
#define ropes (PF(W_ROPE) + (size_t)MP * 32)
#define xbuf outl
    LAS unsigned* misc = (LAS unsigned*)(lds + LDS_MAIN);
    if (threadIdx.x < 4) misc[8 + threadIdx.x] = 0u;
    __syncthreads();
    (void)xcd_barrier_post((unsigned*)(P.ws + W_CTR) + 1024, (volatile LAS unsigned*)(misc + 8));
    grid.sync();

    { LAS float* finv = (LAS float*)(lds + LDS_MAIN + 256);
#pragma unroll
      for (int d = 0; d < 32; ++d) if (tid == d) finv[d] = P.inv_freq[d];
      __syncthreads();
      for (int idx = bid * 512 + tid; idx < MP * 32; idx += G * 512) { const int pos = idx >> 5, d = idx & 31; const float ang = (float)pos * finv[d];
          double rev = (double)ang * 0.15915494309189535; rev -= floor(rev); const float fr = (float)rev;
          ropec[idx] = __builtin_amdgcn_cosf(fr); ropes[idx] = __builtin_amdgcn_sinf(fr); }
      __syncthreads();
    }
    { LAS float* scr = (LAS float*)(lds + wid * 8448);
      for (int it = gw; it < 24320; it += NGW) { int r = it;
          if (r < 16896) { const int lf = r / 4224; r -= lf * 4224;
              if (r < 2816) transpose_item(P.w_gate + (size_t)lf * DM * DFF, P.w_up + (size_t)lf * DM * DFF, DFF, DM, 1, WGU + (size_t)lf * NGU * DM, scr, r, 176, lane);
              else transpose_item(P.w_down + (size_t)lf * DFF * DM, nullptr, DM, DFF, 0, WD + (size_t)lf * DM * DFF, scr, r - 2816, 32, lane);
          } else { r -= 16896; const int l = r / 3712; r -= l * 3712;
              if (r < 2688) transpose_item(P.w_in + (size_t)l * DM * 5136, nullptr, 5136, DM, 2, WIN + (size_t)l * ZP * DM, scr, r, 168, lane);
              else if (r < 2944) transpose_item(P.w_out_a + (size_t)l * 512 * DM, nullptr, DM, 512, 0, WOA + (size_t)l * DM * 512, scr, r - 2688, 32, lane);
              else if (r < 3200) transpose_item(P.w_out_b + (size_t)l * 512 * DM, nullptr, DM, 512, 0, WOB + (size_t)l * DM * 512, scr, r - 2944, 32, lane);
              else transpose_item(P.w_out + (size_t)l * DM * DM, nullptr, DM, DM, 0, WO + (size_t)l * DM * DM, scr, r - 3200, 32, lane); } }
    }
    rownorm_phase(P.x_prompt, P.x_sample, xbuf, nullptr, nullptr, 0.f, P.norm_g, H, gw, NGW, lane);
    GSYNC();

#pragma unroll
    for (int l = 0; l < 2; ++l) {
        const float* ng = P.norm_g + (size_t)l * 6 * DM;
        run_gemm(lds, H, WGU + (size_t)(l * 2) * NGU * DM, MALL, NGU, DM, pg8::EpiSwiGLU{ACT, DFF});
        GSYNC();
        run_gemm(lds, ACT, WD + (size_t)(l * 2) * DM * DFF, MP, DM, DFF, pg8::EpiPlain{Y, DM});
        gemm_small<0>(lds, ACT + (size_t)MP * DFF, WD + (size_t)(l * 2) * DM * DFF, DFF, nullptr, nullptr, 0, Y + (size_t)MP * DM, DM, nullptr);
        GSYNC();
        rownorm_phase(xbuf, xbuf + (size_t)MP * DM, xbuf, Y, ng + 1 * DM, 0.5f, ng + 2 * DM, H, gw, NGW, lane);
        GSYNC();
        {

                { pg8::EpiInProj E{Z, ZP, ropec, ropes, P.out + O_KP + (size_t)l * MP * 512, P.out + O_VP + (size_t)l * MP * 512, P.out + O_KS + (size_t)l * MS * 512, P.out + O_VS + (size_t)l * MS * 512,
                                   KC + (size_t)l * 32 * KCROWS * 512, VC + (size_t)l * 32 * KCROWS * 512, QSCALE};
                  run_gemm(lds, H, WIN + (size_t)l * ZP * DM, MALL, ZP, DM, E); }
                GSYNC();
#if defined(STOP_AT) && STOP_AT == 2
                return;
#endif
                const float* wgu = P.w_gate_up + (size_t)l * 16 * 256; const float* bgp = P.b_gate + (size_t)l * 256;
                for (int u = bid; u < NCHUNK * 4; u += G) { const int n = u >> 2, h = u & 3;
                    gla_unit<0>(lds, Z + (size_t)(64 * n) * ZP, 64, wgu, bgp, h, DS + (size_t)u * 8192, DEC + (size_t)u * 64, nullptr, nullptr, nullptr, nullptr); }
                GSYNC();
                { LAS float* SA = (LAS float*)lds; LAS float* SBv = SA + 512; const int el = tid & 127, sg = tid >> 7;
                  for (int base = bid * 128; base < 32768; base += G * 128) { const int gid = base + el, hd = gid >> 7, e = gid & 127;
                    GAS float* dsp = (GAS float*)(DS + (size_t)hd * 128 + e + (size_t)(64 * sg) * 32768); const GAS float* dcp = (const GAS float*)(DEC + hd + (64 * sg) * 256);
                    float A = 1.f, B = 0.f;
                    for (int n = 0; n < 64; n += 16) { float v[16], c[16];
#pragma unroll
                        for (int j = 0; j < 16; ++j) { v[j] = dsp[(size_t)(n + j) * 32768]; c[j] = dcp[(n + j) * 256]; }
#pragma unroll
                        for (int j = 0; j < 16; ++j) { B = c[j] * B + v[j]; A *= c[j]; } }
                    SA[sg * 128 + el] = A; SBv[sg * 128 + el] = B;
                    __syncthreads();
                    float S = 0.f;
#pragma unroll
                    for (int q = 0; q < 3; ++q) if (q < sg) S = SA[q * 128 + el] * S + SBv[q * 128 + el];
                    for (int n = 0; n < 64; n += 16) { float v[16], c[16];
#pragma unroll
                        for (int j = 0; j < 16; ++j) { v[j] = dsp[(size_t)(n + j) * 32768]; c[j] = dcp[(n + j) * 256]; }
#pragma unroll
                        for (int j = 0; j < 16; ++j) { const float prev = S; S = c[j] * S + v[j]; dsp[(size_t)(n + j) * 32768] = prev; } }
                    if (sg == 3) P.out[O_SP + (size_t)l * 32768 + gid] = S;
                    __syncthreads(); } }
                GSYNC();
                { int lq = l; asm volatile("" : "+s"(lq)); const float lam_init = (lq == 0) ? 0.2f : 0.35550906f; const float* lf = P.lambda_p + (size_t)l * 256;
                  const float lam_v = __expf(wave_sum(lf[lane] * lf[64 + lane])) - __expf(wave_sum(lf[128 + lane] * lf[192 + lane])) + lam_init;
                  const float lam = __uint_as_float(__builtin_amdgcn_readfirstlane(__float_as_uint(lam_v)));
                  const float osc = __uint_as_float(__builtin_amdgcn_readfirstlane(__float_as_uint(1.f - lam_init)));
                  const float* subg = P.subln_g + (size_t)l * 128; const float* glang = P.gla_norm_g + (size_t)l * 128;
                  const bf16_t* KCl = KC + (size_t)l * 32 * KCROWS * 512; const bf16_t* VCl = VC + (size_t)l * 32 * KCROWS * 512;
                  const unsigned hq0 = xb_xcc_id() & 3u; unsigned exh = 0u;
                  for (;;) {
                      if (tid == 0) { unsigned code = 0xffffffffu;
                          for (unsigned kq = 0; kq < 4u && code == 0xffffffffu; ++kq) { const unsigned hh = (hq0 + kq) & 3u;
                              if (!((exh >> hh) & 1u)) { const unsigned idx = atomicAdd(&ctr[l * 16 + hh], 1u); if (idx < 160u) code = (idx < 112u) ? ((127u - idx) * 4u + hh) : (idx < 144u) ? (512u + (idx - 112u) * 4u + hh) : ((15u - (idx - 144u)) * 4u + hh); else exh |= 1u << hh; } }
                          if (code == 0xffffffffu) { const unsigned idx = atomicAdd(&ctr[l * 16 + 4], 1u); if (idx < 1152u) code = 640u + idx; }
                          misc[0] = code; }
                      __syncthreads();
                      const unsigned u = misc[0];
                      __syncthreads();
                      if (u == 0xffffffffu) break;
                      if (u < 640u) {
#ifndef SKIP_ATTN
                          int smp = 0, qb = 0, h = (int)(u & 3), b = 0;
                          if (u < 512u) qb = (int)(u >> 2); else { smp = 1; b = (int)((u - 512u) >> 2); }
                          if (!smp) { const int q0 = 128 * qb;
                              attn_unit(lds, Z + (size_t)q0 * ZP + QA_OFF + 128 * h, ZP, 127, Z + KA_OFF + 128 * h, Z + VA_OFF + 128 * h, ZP, nullptr, nullptr, 2 * qb + 2, 64, 0, q0, OA + (size_t)q0 * OP + 128 * h, 128, lam, subg, osc);
                          } else { const int R0 = MP + 16 * b;
                              attn_unit(lds, Z + (size_t)R0 * ZP + QA_OFF + 128 * h, ZP, 15, KCl + (size_t)b * KCROWS * 512 + 128 * h, VCl + (size_t)b * KCROWS * 512 + 128 * h, 512, P.cache_k + ((size_t)(l * 32 + b) * PAST) * 512 + 128 * h, P.cache_v + ((size_t)(l * 32 + b) * PAST) * 512 + 128 * h, 33, 16, 1, 0, OA + (size_t)R0 * OP + 128 * h, 16, lam, subg, osc); }
#endif
                      } else if (u < 1664u) { const int v = (int)u - 640, n = v >> 2, h = v & 3;
#ifndef SKIP_GLA12
                          gla_unit<1>(lds, Z + (size_t)(64 * n) * ZP, 64, wgu, bgp, h, nullptr, nullptr, DS + (size_t)v * 8192, nullptr, glang, OB + (size_t)(64 * n) * OP + 128 * h);
#endif
                      } else { const int v = (int)u - 1664, b = v >> 2, h = v & 3; const int R0 = MP + 16 * b;
#ifndef SKIP_GLA12
                          gla_unit<2>(lds, Z + (size_t)R0 * ZP, 16, wgu, bgp, h, nullptr, nullptr, P.state_gla + ((size_t)(l * 32 + b) * 4 + h) * 8192, P.out + O_SS + ((size_t)(l * 32 + b) * 4 + h) * 8192, glang, OB + (size_t)R0 * OP + 128 * h);
#endif
 }
                  } }
                GSYNC();
                run_gemm(lds, OA, WOA + (size_t)l * DM * 512, MP, DM, 512, pg8::EpiGate<false>{MIX, nullptr, DM, Z + GA_OFF, ZP});
                run_gemm(lds, OB, WOB + (size_t)l * DM * 512, MP, DM, 512, pg8::EpiGate<true>{MIX, MIX, DM, Z + GB_OFF, ZP});
                gemm_small<1>(lds, OA + (size_t)MP * OP, WOA + (size_t)l * DM * 512, 512, OB + (size_t)MP * OP, WOB + (size_t)l * DM * 512, 512, MIX + (size_t)MP * DM, DM, Z + (size_t)MP * ZP);
                GSYNC();
                run_gemm(lds, MIX, WO + (size_t)l * DM * DM, MP, DM, DM, pg8::EpiPlain{Y, DM});
                gemm_small<0>(lds, MIX + (size_t)MP * DM, WO + (size_t)l * DM * DM, DM, nullptr, nullptr, 0, Y + (size_t)MP * DM, DM, nullptr);
                GSYNC();
                rownorm_phase(xbuf, xbuf + (size_t)MP * DM, xbuf, Y, ng + 3 * DM, 1.0f, ng + 4 * DM, H, gw, NGW, lane);
                GSYNC();
#if defined(STOP_AT) && STOP_AT == 4
                return;
#endif

        }
        run_gemm(lds, H, WGU + (size_t)(l * 2 + 1) * NGU * DM, MALL, NGU, DM, pg8::EpiSwiGLU{ACT, DFF});
        GSYNC();
        run_gemm(lds, ACT, WD + (size_t)(l * 2 + 1) * DM * DFF, MP, DM, DFF, pg8::EpiPlain{Y, DM});
        gemm_small<0>(lds, ACT + (size_t)MP * DFF, WD + (size_t)(l * 2 + 1) * DM * DFF, DFF, nullptr, nullptr, 0, Y + (size_t)MP * DM, DM, nullptr);
        GSYNC();
        if (l == 0) { rownorm_phase(xbuf, xbuf + (size_t)MP * DM, xbuf, Y, ng + 5 * DM, 0.5f, P.norm_g + 6 * DM, H, gw, NGW, lane); GSYNC(); }
        else rownorm_phase(xbuf, xbuf + (size_t)MP * DM, xbuf, Y, ng + 5 * DM, 0.5f, nullptr, nullptr, gw, NGW, lane);
    }
}

#undef WSB
#undef NEWPHASE
#undef GSYNC
#undef PB
#undef PF
#undef ctr
#undef WGU
#undef WD
#undef WIN
#undef WOA
#undef WOB
#undef WO
#undef H
#undef ACT
#undef Y
#undef Z
#undef OA
#undef OB
#undef MIX
#undef KC
#undef VC
#undef DS
#undef DEC
#undef ropec
#undef ropes
#undef xbuf
extern "C" void kernel_launch(void* const* d_in, const int* in_sizes, int n_in, void* d_out, int out_size, void* d_ws, size_t ws_size, hipStream_t stream) {
    static int grid_blocks = 0;
    if (grid_blocks == 0) {
        if (n_in != 18 || (size_t)out_size != O_END || ws_size < W_END) { fprintf(stderr, "kernel_launch: unexpected sizes n_in %d out %d ws %zu (need %zu)\n", n_in, out_size, ws_size, (size_t)W_END); grid_blocks = -1; return; }
        int dev = 0, cus = 0, per_cu = 0;
        hipGetDevice(&dev); hipDeviceGetAttribute(&cus, hipDeviceAttributeMultiprocessorCount, dev);
        if (hipFuncSetAttribute((const void*)mega_fwd, hipFuncAttributeMaxDynamicSharedMemorySize, LDS_TOTAL) != hipSuccess) { fprintf(stderr, "kernel_launch: hipFuncSetAttribute failed\n"); grid_blocks = -1; return; }
        if (hipOccupancyMaxActiveBlocksPerMultiprocessor(&per_cu, (const void*)mega_fwd, 512, LDS_TOTAL) != hipSuccess || per_cu < 1) { fprintf(stderr, "kernel_launch: occupancy query gave %d\n", per_cu); per_cu = 1; }
        (void)hipGetLastError();
        grid_blocks = cus * 1;
    }
    if (grid_blocks < 0) return;
    Params p{};
    const float** pp = (const float**)&p;
    for (int i = 0; i < 18; ++i) pp[i] = (const float*)d_in[i];
    p.out = (float*)d_out; p.ws = (unsigned char*)d_ws;
    for (int d = 0; d < 32; ++d) p.inv_freq[d] = (float)exp(-log(10000.0) * (double)d / 32.0);
    if (hipMemsetAsync((char*)d_ws + W_CTR, 0, 65536, stream) != hipSuccess) { fprintf(stderr, "kernel_launch: memset failed\n"); return; }
    void* args[] = {&p};
    hipError_t e = hipLaunchCooperativeKernel((const void*)mega_fwd, dim3(grid_blocks), dim3(512), args, LDS_TOTAL, stream);
    if (e != hipSuccess) fprintf(stderr, "cooperative launch failed: %s (grid %d)\n", hipGetErrorString(e), grid_blocks);
}
```

```cpp
#include <hip/hip_runtime.h>
#include <hip/hip_cooperative_groups.h>
#include <cstdio>
#include <cstdint>
#include <cmath>
namespace cg = cooperative_groups;
#define GAS __attribute__((address_space(1)))
namespace pg8 {
#define PG8_LAS __attribute__((address_space(3)))
typedef unsigned short bf16_t;
typedef short bf16x8 __attribute__((ext_vector_type(8)));
typedef float f32x4 __attribute__((ext_vector_type(4)));
typedef unsigned u32x4 __attribute__((ext_vector_type(4)));
constexpr int BM = 256, BK = 64, HALF = 128, HTB = HALF * BK * 2  , STAGE_BYTES = 8 * HTB, NXCD = 8, WGM = 4;

__host__ __device__ __forceinline__ int lds_byte(int r, int c) { const int st = (r >> 4) * 2 + (c >> 5), rr = r & 15, cc = c & 31, ob = rr * 64 + cc * 2; return st * 1024 + (ob ^ (((ob >> 9) & 1) << 5)); }
__host__ __device__ __forceinline__ void stage_rc(int b, int& R, int& C) { const int st = b / 1024, sb = b % 1024, swz = sb ^ (((sb >> 9) & 1) << 5); R = (st >> 1) * 16 + swz / 64; C = (st & 1) * 32 + (swz % 64) / 2; }
__host__ __device__ __forceinline__ int perm32(int rho) { const int n = rho >> 4, i = rho & 15; return 8 * (i >> 2) + 4 * n + (i & 3); }

struct Unit { int pm, pn; };
struct Gemm { const bf16_t* A; const bf16_t* Bt; int M, N, K; };

struct StaticOrder {
    int nM, nN, nwg, G, c;
    __host__ __device__ void init(int M, int N, int G_, int c_) { nM = M / BM; nN = N / BM; nwg = nM * nN; G = G_; c = c_; }
    __host__ __device__ bool next(int i, Unit& u) const {
        const long L = (long)i * G + c; if (L >= nwg) return false;
        int wgid = (int)L; { const int q = nwg / NXCD, r = nwg % NXCD, xcd = wgid % NXCD, off = wgid / NXCD; wgid = (xcd < r ? xcd * (q + 1) : r * (q + 1) + (xcd - r) * q) + off; }
        const int nig = WGM * nN, gid = wgid / nig, fm = gid * WGM, gsz = (nM - fm) < WGM ? (nM - fm) : WGM;
        u.pm = fm + ((wgid % nig) % gsz); u.pn = (wgid % nig) / gsz; return true;
    }
    __device__ __forceinline__ void a_ready(const Unit&) const {}
    __device__ __forceinline__ void done(const Unit&) const {}
};

__device__ __forceinline__ unsigned cvt_pk_bf16(float lo, float hi) { unsigned r; asm volatile("v_cvt_pk_bf16_f32 %0, %1, %2" : "=v"(r) : "v"(lo), "v"(hi)); return r; }
typedef float f32x2 __attribute__((ext_vector_type(2)));
__device__ __forceinline__ float fast_sigmoid(float x) { return __builtin_amdgcn_rcpf(1.0f + __builtin_amdgcn_exp2f(-1.4426950408889634f * x)); }
__device__ __forceinline__ float bf2f(bf16_t b) { return __uint_as_float(((unsigned)b) << 16); }
__device__ __forceinline__ u32x4 pack8(const f32x4& v0, const f32x4& v1) { u32x4 w; w.x = cvt_pk_bf16(v0[0], v0[1]); w.y = cvt_pk_bf16(v0[2], v0[3]); w.z = cvt_pk_bf16(v1[0], v1[1]); w.w = cvt_pk_bf16(v1[2], v1[3]); return w; }
__device__ __forceinline__ void unpack8(const u32x4& w, f32x4& v0, f32x4& v1) {
    v0[0] = __uint_as_float(w.x << 16); v0[1] = __uint_as_float(w.x & 0xffff0000u); v0[2] = __uint_as_float(w.y << 16); v0[3] = __uint_as_float(w.y & 0xffff0000u);
    v1[0] = __uint_as_float(w.z << 16); v1[1] = __uint_as_float(w.z & 0xffff0000u); v1[2] = __uint_as_float(w.w << 16); v1[3] = __uint_as_float(w.w & 0xffff0000u); }

struct EpiPlain {
    static constexpr bool PERM = true, AFTER_DRAIN = false;
    bf16_t* O; int ldc;
    __device__ __forceinline__ void operator()(const f32x4 (&acc)[2][2][4][2], const Unit& u, int wr, int wc, int fr, int fq) const {
        const int row0 = u.pm * BM + wr * 64 + fr, col0 = u.pn * BM + wc * 32 + 8 * fq;
#pragma unroll
        for (int ai = 0; ai < 2; ++ai)
#pragma unroll
            for (int m = 0; m < 4; ++m) { bf16_t* rowp = O + (size_t)(row0 + ai * HALF + m * 16) * ldc + col0;
#pragma unroll
                for (int bj = 0; bj < 2; ++bj) *(GAS u32x4*)(rowp + bj * HALF) = pack8(acc[ai][bj][m][0], acc[ai][bj][m][1]); }
    }
};
struct EpiSwiGLU {
    static constexpr bool PERM = true, AFTER_DRAIN = false;
    bf16_t* O; int ldc;
    __device__ __forceinline__ void operator()(const f32x4 (&acc)[2][2][4][2], const Unit& u, int wr, int wc, int fr, int fq) const {
        const int row0 = u.pm * BM + wr * 64 + fr, col0 = u.pn * HALF + wc * 32 + 8 * fq;
#pragma unroll
        for (int ai = 0; ai < 2; ++ai)
#pragma unroll
            for (int m = 0; m < 4; ++m) { bf16_t* rowp = O + (size_t)(row0 + ai * HALF + m * 16) * ldc + col0;
                f32x4 r0, r1;
#pragma unroll
                for (int i = 0; i < 4; ++i) { const float g0 = acc[ai][0][m][0][i], g1 = acc[ai][0][m][1][i];
                    r0[i] = g0 * fast_sigmoid(g0) * acc[ai][1][m][0][i]; r1[i] = g1 * fast_sigmoid(g1) * acc[ai][1][m][1][i]; }
                *(GAS u32x4*)rowp = pack8(r0, r1); }
    }
};
template <bool ADD> struct EpiGate {
    static constexpr bool PERM = true, AFTER_DRAIN = false;
    bf16_t* O; const bf16_t* P; int ldc; const bf16_t* G; int ldg;
    __device__ __forceinline__ void operator()(const f32x4 (&acc)[2][2][4][2], const Unit& u, int wr, int wc, int fr, int fq) const {
        const int row0 = u.pm * BM + wr * 64 + fr, col0 = u.pn * BM + wc * 32 + 8 * fq;
        u32x4 gq[2][2], pq[2][2];
#define EG_LOAD(IT, SL) do { const size_t row_ = (size_t)(row0 + ((IT) >> 2) * HALF + ((IT) & 3) * 16); \
            _Pragma("unroll") for (int bj = 0; bj < 2; ++bj) { gq[SL][bj] = *(const GAS u32x4*)(G + row_ * ldg + col0 + bj * HALF); if (ADD) pq[SL][bj] = *(const GAS u32x4*)(P + row_ * ldc + col0 + bj * HALF); } } while (0)
        EG_LOAD(0, 0);
#pragma unroll
        for (int it = 0; it < 8; ++it) { const int ai = it >> 2, m = it & 3; const size_t row = (size_t)(row0 + ai * HALF + m * 16);
            if (it + 1 < 8) { if ((it & 1) == 0) EG_LOAD(it + 1, 1); else EG_LOAD(it + 1, 0); }
#pragma unroll
            for (int bj = 0; bj < 2; ++bj) { const int col = col0 + bj * HALF;
                f32x4 g0, g1; unpack8(gq[it & 1][bj], g0, g1);
                f32x4 p0 = {0.f, 0.f, 0.f, 0.f}, p1 = {0.f, 0.f, 0.f, 0.f};
                if (ADD) unpack8(pq[it & 1][bj], p0, p1);
                f32x4 r0, r1;
#pragma unroll
                for (int i = 0; i < 4; ++i) { r0[i] = p0[i] + fast_sigmoid(g0[i]) * acc[ai][bj][m][0][i]; r1[i] = p1[i] + fast_sigmoid(g1[i]) * acc[ai][bj][m][1][i]; }
                *(GAS u32x4*)(O + row * ldc + col) = pack8(r0, r1); }
            asm volatile("" ::: "memory"); }
#undef EG_LOAD
    }
};
typedef unsigned u32x2 __attribute__((ext_vector_type(2)));
struct EpiInProj {
    static constexpr bool PERM = true, AFTER_DRAIN = false;
    bf16_t* Z; int ldz; const float* ropec; const float* ropes;
    float* kout_p; float* vout_p; float* kout_s; float* vout_s; bf16_t* KC; bf16_t* VC; float qscale;
    __device__ __forceinline__ void operator()(const f32x4 (&acc)[2][2][4][2], const Unit& u, int wr, int wc, int fr, int fq) const {
        const int pn = u.pn; const int row0 = u.pm * BM + wr * 64 + fr;
        if (pn < 4) {
            const bool isk = pn >= 2; const int sec = isk ? 512 : 0, pnl = pn & 1, dbase = 16 * (wc & 1) + 4 * fq;
            f32x4 csq[2], snq[2];
#define EI_LOAD(IT, SL) do { const int row_ = row0 + ((IT) >> 2) * HALF + ((IT) & 3) * 16; const int pos_ = (row_ >= 16384) ? 2048 + ((row_ - 16384) & 15) : row_; \
                csq[SL] = *(const GAS f32x4*)(ropec + pos_ * 32 + dbase); snq[SL] = *(const GAS f32x4*)(ropes + pos_ * 32 + dbase); } while (0)
            EI_LOAD(0, 0);
#pragma unroll
            for (int it = 0; it < 8; ++it) { const int ai = it >> 2, m = it & 3; const int row = row0 + ai * HALF + m * 16; const bool smp = row >= 16384; const int sr = row - 16384;
                    if (it + 1 < 8) { if ((it & 1) == 0) EI_LOAD(it + 1, 1); else EI_LOAD(it + 1, 0); }
                    const f32x4 cs = csq[it & 1], sn = snq[it & 1];
#pragma unroll
                    for (int bj = 0; bj < 2; ++bj) { const int head = 4 * pnl + 2 * bj + (wc >> 1);
                        const f32x4 a0 = acc[ai][bj][m][0], a1 = acc[ai][bj][m][1];
                        const f32x4 x1 = {a0[0], a0[2], a1[0], a1[2]}, x2 = {a0[1], a0[3], a1[1], a1[3]};
                        f32x4 y1 = x1 * cs - x2 * sn, y2 = x2 * cs + x1 * sn;
                        const int hc = head * 64 + dbase;
                        if (isk) {
                            float* ko = smp ? kout_s + (size_t)sr * 512 + hc : kout_p + (size_t)row * 512 + hc;
                            *(GAS f32x4*)ko = y1; *(GAS f32x4*)(ko + 32) = y2;
                        } else { y1 = y1 * qscale; y2 = y2 * qscale; }
                        u32x2 w1, w2; w1.x = cvt_pk_bf16(y1[0], y1[1]); w1.y = cvt_pk_bf16(y1[2], y1[3]); w2.x = cvt_pk_bf16(y2[0], y2[1]); w2.y = cvt_pk_bf16(y2[2], y2[3]);
                        bf16_t* zp = Z + (size_t)row * ldz + sec + hc; *(GAS u32x2*)zp = w1; *(GAS u32x2*)(zp + 32) = w2;
                        if (isk && smp) { bf16_t* kc = KC + ((size_t)(sr >> 4) * 2112 + 2048 + (sr & 15)) * 512 + hc; *(GAS u32x2*)kc = w1; *(GAS u32x2*)(kc + 32) = w2; } }
                    asm volatile("" ::: "memory"); }
#undef EI_LOAD
        } else {
            const int col0 = pn * BM + wc * 32 + 8 * fq; const float sc = (pn == 6) ? 0.125f : 1.0f; const bool isv = (pn == 4 || pn == 5);
#pragma unroll
            for (int ai = 0; ai < 2; ++ai)
#pragma unroll
                for (int m = 0; m < 4; ++m) { const int row = row0 + ai * HALF + m * 16; const bool smp = row >= 16384; const int sr = row - 16384;
#pragma unroll
                    for (int bj = 0; bj < 2; ++bj) { const int col = col0 + bj * HALF;
                        const f32x4 v0 = acc[ai][bj][m][0] * sc, v1 = acc[ai][bj][m][1] * sc; const u32x4 w = pack8(v0, v1);
                        *(GAS u32x4*)(Z + (size_t)row * ldz + col) = w;
                        if (isv) { const int vc = col - 1024; float* vo = smp ? vout_s + (size_t)sr * 512 + vc : vout_p + (size_t)row * 512 + vc;
                            *(GAS f32x4*)vo = v0; *(GAS f32x4*)(vo + 4) = v1;
                            if (smp) *(GAS u32x4*)(VC + ((size_t)(sr >> 4) * 2112 + 2048 + (sr & 15)) * 512 + vc) = w; } }
                    asm volatile("" ::: "memory"); }
        }
    }
};

struct PanelRms {
    unsigned* xs;
    unsigned* cnt;
    float eps;
    __device__ __forceinline__ void run(const f32x4 (&v)[2][2][4][2], const Unit& u, int wr, int wc, int fr, int fq, PG8_LAS unsigned char* lds, int wid, int lane) const {
        PG8_LAS float* P = (PG8_LAS float*)lds;
        PG8_LAS float* S = (PG8_LAS float*)(lds + 4096);
#pragma unroll
        for (int ai = 0; ai < 2; ++ai)
#pragma unroll
            for (int m = 0; m < 4; ++m) { float s = 0.f;
#pragma unroll
                for (int bj = 0; bj < 2; ++bj)
#pragma unroll
                    for (int n = 0; n < 2; ++n) { const f32x4 x = v[ai][bj][m][n]; s += (x[0] * x[0] + x[1] * x[1]) + (x[2] * x[2] + x[3] * x[3]); }
                s += __shfl_xor(s, 16); s += __shfl_xor(s, 32);
                if (fq == 0) P[(ai * HALF + wr * 64 + m * 16 + fr) * 4 + wc] = s; }
        asm volatile("s_waitcnt lgkmcnt(0)" ::: "memory"); __builtin_amdgcn_s_barrier(); asm volatile("" ::: "memory");
        const int row = wid * 32 + (lane & 31);
        if (lane < 32) { const float tot = (P[row * 4 + 0] + P[row * 4 + 1]) + (P[row * 4 + 2] + P[row * 4 + 3]);
            __hip_atomic_store(xs + (size_t)(u.pm * BM + row) * 4 + u.pn, __float_as_uint(tot), __ATOMIC_RELAXED, __HIP_MEMORY_SCOPE_AGENT); }
        asm volatile("s_waitcnt vmcnt(0)" ::: "memory");
        if (lane == 0) __hip_atomic_fetch_add(cnt + 64 * u.pm, 1u, __ATOMIC_RELAXED, __HIP_MEMORY_SCOPE_AGENT);
        if (wid == 0) { unsigned sp = 0u;
            while ((unsigned)__builtin_amdgcn_readfirstlane(__hip_atomic_load(cnt + 64 * u.pm, __ATOMIC_RELAXED, __HIP_MEMORY_SCOPE_AGENT)) < 32u) { __builtin_amdgcn_s_sleep(2); if (++sp > (1u << 22)) break; }
            __builtin_amdgcn_fence(__ATOMIC_ACQUIRE, "agent"); }
        asm volatile("s_waitcnt vmcnt(0) lgkmcnt(0)" ::: "memory"); __builtin_amdgcn_s_barrier(); asm volatile("" ::: "memory");
        if (lane < 32) { const unsigned* sl = xs + (size_t)(u.pm * BM + row) * 4; float t = 0.f;
#pragma unroll
            for (int k = 0; k < 4; ++k) t += __uint_as_float(__hip_atomic_load(sl + k, __ATOMIC_RELAXED, __HIP_MEMORY_SCOPE_AGENT));
            S[row] = __builtin_amdgcn_rsqf(t * (1.0f / 1024.0f) + eps); }
        asm volatile("s_waitcnt lgkmcnt(0)" ::: "memory"); __builtin_amdgcn_s_barrier(); asm volatile("" ::: "memory");
    }
};
struct EpiRmsRes {
    static constexpr bool PERM = false, AFTER_DRAIN = true;
    float* x; bf16_t* H; int ldc; const float* ga; float cy; const float* gb; PanelRms st1, st2;
    __device__ __forceinline__ void fused(f32x4 (&acc)[2][2][4][2], const Unit& u, int wr, int wc, int fr, int fq, PG8_LAS unsigned char* lds, int wid, int lane) const {
        const PG8_LAS float* S = (const PG8_LAS float*)(lds + 4096);
        const int col0 = u.pn * BM + wc * 32 + 4 * fq;
        st1.run(acc, u, wr, wc, fr, fq, lds, wid, lane);
        { f32x4 g1[2][2];
#pragma unroll
          for (int bj = 0; bj < 2; ++bj)
#pragma unroll
              for (int n = 0; n < 2; ++n) g1[bj][n] = *(const GAS f32x4*)(ga + col0 + bj * HALF + n * 16) * cy;
#pragma unroll
          for (int ai = 0; ai < 2; ++ai)
#pragma unroll
              for (int m = 0; m < 4; ++m) { const int r = ai * HALF + wr * 64 + m * 16 + fr; const float sr = S[r]; const size_t off = (size_t)(u.pm * BM + r) * ldc + col0;
#pragma unroll
                  for (int bj = 0; bj < 2; ++bj)
#pragma unroll
                      for (int n = 0; n < 2; ++n) { const f32x4 bs = *(const GAS f32x4*)(x + off + bj * HALF + n * 16); acc[ai][bj][m][n] = bs + acc[ai][bj][m][n] * g1[bj][n] * sr; }
                  asm volatile("" : "+v"(acc[ai][0][m][0]), "+v"(acc[ai][0][m][1]), "+v"(acc[ai][1][m][0]), "+v"(acc[ai][1][m][1]));
                  if (m & 1) asm volatile("" ::: "memory"); } }
        const bool two = (gb != nullptr);
        if (two) st2.run(acc, u, wr, wc, fr, fq, lds, wid, lane);
        f32x4 g2[2][2];
#pragma unroll
        for (int bj = 0; bj < 2; ++bj)
#pragma unroll
            for (int n = 0; n < 2; ++n) g2[bj][n] = two ? *(const GAS f32x4*)(gb + col0 + bj * HALF + n * 16) : (f32x4){0.f, 0.f, 0.f, 0.f};
#pragma unroll
        for (int ai = 0; ai < 2; ++ai)
#pragma unroll
            for (int m = 0; m < 4; ++m) { const int r = ai * HALF + wr * 64 + m * 16 + fr; const float sr = S[r]; const size_t off = (size_t)(u.pm * BM + r) * ldc + col0;
#pragma unroll
                for (int bj = 0; bj < 2; ++bj)
#pragma unroll
                    for (int n = 0; n < 2; ++n) { const f32x4 x1 = acc[ai][bj][m][n]; *(GAS f32x4*)(x + off + bj * HALF + n * 16) = x1;
                        if (two) { const f32x4 o = x1 * g2[bj][n] * sr; u32x2 w; w.x = cvt_pk_bf16(o[0], o[1]); w.y = cvt_pk_bf16(o[2], o[3]); *(GAS u32x2*)(H + off + bj * HALF + n * 16) = w; } }
                asm volatile("" ::: "memory"); }
    }
};
template <class Epi, class Sched, bool ALIGN_EPI = false, bool SP2 = false>
__device__ __forceinline__ void gemm_phase(PG8_LAS unsigned char* lds, const Gemm g, const Sched& S, const Epi& E) {
    int tid_ = threadIdx.x; asm volatile("" : "+v"(tid_));
    const int tid = tid_, wid = __builtin_amdgcn_readfirstlane(tid >> 6), lane = tid & 63, wr = wid >> 2, wc = wid & 3, fr = lane & 15, fq = lane >> 4;
    const int K = g.K, nt = K / BK;
    unsigned voffA[2], voffB[2];
#pragma unroll
    for (int i = 0; i < 2; ++i) { int R, C; stage_rc(tid * 16 + i * 8192, R, C); const int Rb = Epi::PERM ? ((R & ~31) + perm32(R & 31)) : R;
        voffA[i] = (unsigned)(R * K + C) * 2u; voffB[i] = (unsigned)(Rb * K + C) * 2u; }
    const size_t kstep = (size_t)(BK * 2);
    const size_t hstep = (size_t)HALF * K * 2;
    const size_t tstep = 2 * hstep;
    const unsigned ldsw = (unsigned)wid * 1024u;
    const int aoff = lds_byte(wr * 64 + fr, fq * 8), boff = lds_byte(wc * 32 + fr, fq * 8);
#define PG8_SA(b, h) (((b) * 2 + (h)) * HTB)
#define PG8_SB(b, h) ((4 + (b) * 2 + (h)) * HTB)
#define PG8_STAGE(bufoff, gbase, voff) do { _Pragma("unroll") for (int _i = 0; _i < 2; ++_i) \
        __builtin_amdgcn_global_load_lds((const unsigned*)((const char*)(gbase) + (voff)[_i]), (PG8_LAS unsigned*)(lds + (bufoff) + ldsw + _i * 8192), 16, 0, 0); } while (0)
#define PG8_LDA(dst, b, h) do { _Pragma("unroll") for (int m = 0; m < 4; ++m) _Pragma("unroll") for (int k = 0; k < 2; ++k) dst[m][k] = *(const PG8_LAS bf16x8*)(lds + PG8_SA(b, h) + aoff + m * 2048 + k * 1024); } while (0)
#define PG8_LDB(dst, b, h) do { _Pragma("unroll") for (int n = 0; n < 2; ++n) _Pragma("unroll") for (int k = 0; k < 2; ++k) dst[n][k] = *(const PG8_LAS bf16x8*)(lds + PG8_SB(b, h) + boff + n * 2048 + k * 1024); } while (0)
#define PG8_MMA(ai, bj, At, Bt) do { __builtin_amdgcn_s_setprio(1); _Pragma("unroll") for (int m = 0; m < 4; ++m) _Pragma("unroll") for (int n = 0; n < 2; ++n) _Pragma("unroll") for (int k = 0; k < 2; ++k) \
        acc[ai][bj][m][n] = __builtin_amdgcn_mfma_f32_16x16x32_bf16(Bt[n][k], At[m][k], acc[ai][bj][m][n], 0, 0, 0); __builtin_amdgcn_s_setprio(0); } while (0)
#define PG8_WAIT_V(n) asm volatile("s_waitcnt vmcnt(" #n ")" ::: "memory")
#define PG8_WAIT_L(n) asm volatile("s_waitcnt lgkmcnt(" #n ")" ::: "memory")
#define PG8_BAR __builtin_amdgcn_s_barrier()
#define PG8_SCHED __builtin_amdgcn_sched_barrier(0)
    Unit cur, nxt; int ui = 0;
    if (!S.next(0, cur)) return;
    f32x4 acc[2][2][4][2];
#pragma unroll
    for (int a = 0; a < 2; ++a)
#pragma unroll
        for (int b = 0; b < 2; ++b)
#pragma unroll
            for (int m = 0; m < 4; ++m)
#pragma unroll
                for (int n = 0; n < 2; ++n) acc[a][b][m][n] = (f32x4){0.f, 0.f, 0.f, 0.f};
    bf16x8 At[4][2], B0[2][2], B1[2][2];
    const char* cA = (const char*)g.A + (size_t)cur.pm * tstep; const char* cB = (const char*)g.Bt + (size_t)cur.pn * tstep;
    S.a_ready(cur);
    if constexpr (SP2) {
        PG8_STAGE(PG8_SB(0, 0), cB, voffB); PG8_STAGE(PG8_SB(0, 1), cB + hstep, voffB); PG8_STAGE(PG8_SA(0, 0), cA, voffA); PG8_STAGE(PG8_SA(0, 1), cA + hstep, voffA);
        if (wr == 1) PG8_BAR;
        PG8_WAIT_V(2); PG8_BAR;
        PG8_STAGE(PG8_SB(1, 0), cB + kstep, voffB); PG8_STAGE(PG8_SA(1, 0), cA + kstep, voffA); PG8_STAGE(PG8_SB(1, 1), cB + hstep + kstep, voffB);
        PG8_WAIT_V(6); PG8_BAR;
    } else {
        PG8_STAGE(PG8_SB(0, 0), cB, voffB); PG8_STAGE(PG8_SA(0, 0), cA, voffA); PG8_STAGE(PG8_SB(0, 1), cB + hstep, voffB); PG8_STAGE(PG8_SA(0, 1), cA + hstep, voffA);
        if (wr == 1) PG8_BAR;
        PG8_WAIT_V(4); PG8_BAR;
        PG8_STAGE(PG8_SB(1, 0), cB + kstep, voffB); PG8_STAGE(PG8_SA(1, 0), cA + kstep, voffA); PG8_STAGE(PG8_SB(1, 1), cB + hstep + kstep, voffB);
        PG8_WAIT_V(6); PG8_BAR;
    }
    for (;;) {
        const bool has_next = S.next(ui + 1, nxt);
        const char* nA = has_next ? (const char*)g.A + (size_t)nxt.pm * tstep : cA; const char* nB = has_next ? (const char*)g.Bt + (size_t)nxt.pn * tstep : cB;
        for (int t = 0; t < nt; t += 2) {
            const bool last = (t == nt - 2);
            const char* a1 = cA + (size_t)(t + 1) * kstep;
            const char* a2 = last ? nA : cA + (size_t)(t + 2) * kstep; const char* b2 = last ? nB : cB + (size_t)(t + 2) * kstep;
            const char* a3 = a2 + kstep; const char* b3 = b2 + kstep;
            if (last && has_next) S.a_ready(nxt);
            if constexpr (SP2) {
            PG8_LDB(B0, 0, 0); PG8_LDB(B1, 0, 1); PG8_SCHED; PG8_LDA(At, 0, 0); PG8_STAGE(PG8_SA(1, 1), a1 + hstep, voffA);
            PG8_WAIT_V(8); PG8_WAIT_L(0); PG8_BAR; PG8_MMA(0, 0, At, B0); PG8_MMA(0, 1, At, B1); PG8_BAR; PG8_SCHED;
            PG8_LDA(At, 0, 1); PG8_STAGE(PG8_SB(0, 0), b2, voffB); PG8_STAGE(PG8_SB(0, 1), b2 + hstep, voffB); PG8_STAGE(PG8_SA(0, 0), a2, voffA);
            PG8_WAIT_V(8); PG8_WAIT_L(0); PG8_BAR; PG8_MMA(1, 0, At, B0); PG8_MMA(1, 1, At, B1); PG8_BAR; PG8_SCHED;
            PG8_LDB(B0, 1, 0); PG8_LDB(B1, 1, 1); PG8_SCHED; PG8_LDA(At, 1, 0); PG8_STAGE(PG8_SA(0, 1), a2 + hstep, voffA);
            PG8_WAIT_V(8); PG8_WAIT_L(0); PG8_BAR; PG8_MMA(0, 0, At, B0); PG8_MMA(0, 1, At, B1); PG8_BAR; PG8_SCHED;
            PG8_LDA(At, 1, 1); PG8_STAGE(PG8_SB(1, 0), b3, voffB); PG8_STAGE(PG8_SB(1, 1), b3 + hstep, voffB); PG8_STAGE(PG8_SA(1, 0), a3, voffA);
            PG8_WAIT_V(8); PG8_WAIT_L(0); PG8_BAR; PG8_MMA(1, 0, At, B0); PG8_MMA(1, 1, At, B1); PG8_BAR; PG8_SCHED;
            } else {
            PG8_LDB(B0, 0, 0); PG8_SCHED; PG8_LDA(At, 0, 0); PG8_STAGE(PG8_SA(1, 1), a1 + hstep, voffA);
            PG8_WAIT_L(8); PG8_BAR; PG8_WAIT_L(0); PG8_MMA(0, 0, At, B0); PG8_BAR; PG8_SCHED;
            PG8_LDB(B1, 0, 1); PG8_STAGE(PG8_SB(0, 0), b2, voffB);
            PG8_BAR; PG8_WAIT_L(0); PG8_MMA(0, 1, At, B1); PG8_BAR;
            PG8_LDA(At, 0, 1); PG8_STAGE(PG8_SA(0, 0), a2, voffA);
            PG8_BAR; PG8_WAIT_L(0); PG8_MMA(1, 0, At, B0); PG8_BAR; PG8_SCHED;
            PG8_STAGE(PG8_SB(0, 1), b2 + hstep, voffB);
            PG8_WAIT_V(6); PG8_BAR; PG8_MMA(1, 1, At, B1); PG8_BAR;
            PG8_LDB(B0, 1, 0); PG8_SCHED; PG8_LDA(At, 1, 0); PG8_STAGE(PG8_SA(0, 1), a2 + hstep, voffA);
            PG8_WAIT_L(8); PG8_BAR; PG8_WAIT_L(0); PG8_MMA(0, 0, At, B0); PG8_BAR; PG8_SCHED;
            PG8_LDB(B1, 1, 1); PG8_STAGE(PG8_SB(1, 0), b3, voffB);
            PG8_BAR; PG8_WAIT_L(0); PG8_MMA(0, 1, At, B1); PG8_BAR;
            PG8_LDA(At, 1, 1); PG8_STAGE(PG8_SA(1, 0), a3, voffA);
            PG8_BAR; PG8_WAIT_L(0); PG8_MMA(1, 0, At, B0); PG8_BAR; PG8_SCHED;
            PG8_STAGE(PG8_SB(1, 1), b3 + hstep, voffB);
            PG8_WAIT_V(6); PG8_BAR; PG8_MMA(1, 1, At, B1); PG8_BAR;
            }
        }
        if constexpr (ALIGN_EPI) { if (wr == 0) PG8_BAR; }
        if constexpr (!Epi::AFTER_DRAIN) { E(acc, cur, wr, wc, fr, fq); S.done(cur); }
        if (!has_next) break;
#pragma unroll
        for (int a = 0; a < 2; ++a)
#pragma unroll
            for (int b = 0; b < 2; ++b)
#pragma unroll
                for (int m = 0; m < 4; ++m)
#pragma unroll
                    for (int n = 0; n < 2; ++n) acc[a][b][m][n] = (f32x4){0.f, 0.f, 0.f, 0.f};
        cur = nxt; cA = nA; cB = nB; ++ui;
        if constexpr (ALIGN_EPI) { if (wr == 1) PG8_BAR; }
    }
    PG8_WAIT_V(0);
    if constexpr (!ALIGN_EPI) { if (wr == 0) PG8_BAR; }
    PG8_BAR;
    if constexpr (Epi::AFTER_DRAIN) { E.fused(acc, cur, wr, wc, fr, fq, lds, wid, lane); S.done(cur); }
#undef PG8_SA
#undef PG8_SB
#undef PG8_STAGE
#undef PG8_LDA
#undef PG8_LDB
#undef PG8_MMA
#undef PG8_WAIT_V
#undef PG8_WAIT_L
#undef PG8_BAR
#undef PG8_SCHED
}
}
using pg8::bf16_t; using pg8::bf16x8; using pg8::f32x4; using pg8::u32x4; using pg8::u32x2; using pg8::cvt_pk_bf16; using pg8::bf2f;
#define LAS __attribute__((address_space(3)))
typedef float f32x16 __attribute__((ext_vector_type(16)));
typedef short s16x4 __attribute__((ext_vector_type(4)));

constexpr int DM = 1024, MP = 16384, MS = 512, MALL = MP + MS, DFF = 2816, NGU = 2 * DFF, ZP = 5376, PAST = 2048, KCROWS = 2112;
constexpr int QA_OFF = 0, KA_OFF = 512, VA_OFF = 1024, QB_OFF = 1536, KB_OFF = 1792, VB_OFF = 2048, RB_OFF = 2560, GA_OFF = 3072, GB_OFF = 4096, ALR_OFF = 5120;
constexpr int NCHUNK = 256;
constexpr int OP = 512;
constexpr size_t O_Y = 0, O_KP = (size_t)MALL * DM, O_VP = O_KP + 2ull * MP * 512, O_SP = O_VP + 2ull * MP * 512, O_KS = O_SP + 2ull * 4 * 64 * 128,
                 O_VS = O_KS + 2ull * MS * 512, O_SS = O_VS + 2ull * MS * 512, O_END = O_SS + 2ull * 32 * 4 * 64 * 128;
constexpr size_t al256(size_t x) { return (x + 255) & ~(size_t)255; }
constexpr size_t W_CTR = 0;
constexpr size_t W_WGU = 65536;
constexpr size_t W_WD = W_WGU + 4ull * NGU * DM * 2;
constexpr size_t W_WIN = W_WD + 4ull * DM * DFF * 2;
constexpr size_t W_WOA = W_WIN + 2ull * ZP * DM * 2;
constexpr size_t W_WOB = W_WOA + 2ull * DM * 512 * 2;
constexpr size_t W_WO = W_WOB + 2ull * DM * 512 * 2;
constexpr size_t W_H = W_WO + 2ull * DM * DM * 2;
constexpr size_t W_ACT = W_H + (size_t)MALL * DM * 2;
constexpr size_t W_Y = W_ACT + (size_t)MALL * DFF * 2;
constexpr size_t W_Z = W_Y + (size_t)MALL * DM * 2;
constexpr size_t W_OAB = W_Z + (size_t)MALL * ZP * 2;
constexpr size_t W_MIX = W_OAB + (size_t)MALL * DM * 2;
constexpr size_t W_KC = W_MIX + (size_t)MALL * DM * 2;
constexpr size_t W_VC = W_KC + 2ull * 32 * KCROWS * 512 * 2;
constexpr size_t W_DS = W_VC + 2ull * 32 * KCROWS * 512 * 2;
constexpr size_t W_DEC = W_DS + (size_t)NCHUNK * 4 * 64 * 128 * 4;
constexpr size_t W_ROPE = W_DEC + (size_t)NCHUNK * 4 * 64 * 4;
constexpr size_t W_END = W_ROPE + 2ull * MP * 32 * 4;

constexpr int LDS_MAIN = 131072, LDS_TOTAL = LDS_MAIN + 1024;

struct Params {
    const float *x_prompt, *x_sample, *cache_k, *cache_v, *state_gla, *norm_g, *w_gate, *w_up, *w_down, *w_in, *w_gate_up, *b_gate, *lambda_p, *subln_g, *gla_norm_g, *w_out_a, *w_out_b, *w_out;
    float* out; unsigned char* ws;
    float inv_freq[32];
};

__device__ __forceinline__ float wave_sum(float v) {
#pragma unroll
    for (int o = 1; o < 64; o <<= 1) v += __shfl_xor(v, o);
    return v;
}
__device__ __forceinline__ float swap32_add(float v) { auto rr = __builtin_amdgcn_permlane32_swap(__float_as_uint(v), __float_as_uint(v), false, false); return __uint_as_float(rr[0]) + __uint_as_float(rr[1]); }
__device__ __forceinline__ float swap32_max(float v) { auto rr = __builtin_amdgcn_permlane32_swap(__float_as_uint(v), __float_as_uint(v), false, false); return fmaxf(__uint_as_float(rr[0]), __uint_as_float(rr[1])); }
__device__ __forceinline__ float max3f(float a, float b, float c) { float r; asm("v_max3_f32 %0, %1, %2, %3" : "=v"(r) : "v"(a), "v"(b), "v"(c)); return r; }
__device__ __forceinline__ float fadd_s(float a, float b) { float r; asm("v_add_f32_e32 %0, %1, %2" : "=v"(r) : "v"(a), "v"(b)); return r; }
__device__ __forceinline__ int crow(int r, int hi) { return (r & 3) + 8 * (r >> 2) + 4 * hi; }
__device__ __forceinline__ unsigned f2bf(float f) { unsigned u = __float_as_uint(f); return (u + 0x7fffu + ((u >> 16) & 1u)) >> 16; }

__device__ __forceinline__ const float* tr_src(const float* W0, const float* W1, int mode, int np) {
    if (mode == 0) return W0 + np;
    if (mode == 1) { const int r = np & 255, pn = np >> 8; return (r < 128 ? W0 : W1) + 128 * pn + (r & 127); }
    if (np < 1024) { const int j = np & 63; return W0 + (np & ~63) + (j >> 1) + 32 * (j & 1); }
    if (np < 3072) return W0 + np;
    if (np < 5120) return W0 + np + 16;
    if (np < 5136) return W0 + 3072 + (np - 5120);
    return nullptr;
}
__device__ __forceinline__ void transpose_item(const float* W0, const float* W1, int Nsrc, int K, int mode, bf16_t* WT, LAS float* scr, int item, int nblk, int lane) {
    const int kb = item / nblk, nb = item % nblk, k0 = 64 * kb, n0 = 32 * nb;
    if (mode == 2 && n0 < 1024) {
        const float* src = tr_src(W0, W1, mode, n0 + (lane & 31));
#pragma unroll 8
        for (int i = 0; i < 32; ++i) { const int kk = 2 * i + (lane >> 5); scr[kk * 33 + (lane & 31)] = src[(size_t)(k0 + kk) * Nsrc]; }
    } else {
        const int n4 = 4 * (lane & 7); const float* src = tr_src(W0, W1, mode, n0 + n4);
#pragma unroll
        for (int i = 0; i < 8; ++i) { const int kk = 8 * i + (lane >> 3); f32x4 v = {0.f, 0.f, 0.f, 0.f}; if (src) v = *(const GAS f32x4*)(src + (size_t)(k0 + kk) * Nsrc);
            LAS float* d = scr + kk * 33 + n4; d[0] = v[0]; d[1] = v[1]; d[2] = v[2]; d[3] = v[3]; }
    }
    asm volatile("s_waitcnt lgkmcnt(0)" ::: "memory");
    const int c = lane & 7;
#pragma unroll
    for (int j = 0; j < 4; ++j) { const int n = (lane >> 3) + 8 * j; const LAS float* s = scr + (8 * c) * 33 + n;
        u32x4 o; o.x = cvt_pk_bf16(s[0 * 33], s[1 * 33]); o.y = cvt_pk_bf16(s[2 * 33], s[3 * 33]); o.z = cvt_pk_bf16(s[4 * 33], s[5 * 33]); o.w = cvt_pk_bf16(s[6 * 33], s[7 * 33]);
        *(GAS u32x4*)(WT + (size_t)(n0 + n) * K + k0 + 8 * c) = o; }
    asm volatile("s_waitcnt lgkmcnt(0)" ::: "memory");
}

template <int MODE> __device__ __forceinline__ void gemm_small(LAS unsigned char* lds, const bf16_t* A0, const bf16_t* B0, int K0, const bf16_t* A1, const bf16_t* B1, int K1, bf16_t* O, int ldo, const bf16_t* Zs) {
    int tid_ = threadIdx.x; asm volatile("" : "+v"(tid_));
    const int tid = tid_, lane = tid & 63, wid = __builtin_amdgcn_readfirstlane(tid >> 6), r32 = lane & 31, hi = lane >> 5;
    constexpr int NP = MODE == 1 ? 2 : 1;
    LAS float* R = (LAS float*)lds;
    for (int u = blockIdx.x; u < 256; u += gridDim.x) { const int um = u >> 4, un = u & 15;
        f32x16 acc[NP][2];
#pragma unroll
        for (int p = 0; p < NP; ++p)
#pragma unroll
            for (int cb = 0; cb < 2; ++cb)
#pragma unroll
                for (int r = 0; r < 16; ++r) acc[p][cb][r] = 0.f;
#pragma unroll
        for (int p = 0; p < NP; ++p) { const bf16_t* A = p ? A1 : A0; const bf16_t* B = p ? B1 : B0; const int K = p ? K1 : K0;
            const bf16_t* ap = A + (size_t)(32 * um + r32) * K + 8 * hi; const bf16_t* bp0 = B + (size_t)(64 * un + r32) * K + 8 * hi; const bf16_t* bp1 = bp0 + (size_t)32 * K;
            const int nks = K >> 4, per = nks >> 3, kb0 = wid * per;
            for (int ks = 0; ks < per; ks += 4) { bf16x8 a[4], b0[4], b1[4];
#pragma unroll
                for (int j = 0; j < 4; ++j) { const int kk = ks + j; const int kc = kb0 + ((kk < per) ? kk : 0);
                    a[j] = *(const GAS bf16x8*)(ap + 16 * kc); b0[j] = *(const GAS bf16x8*)(bp0 + 16 * kc); b1[j] = *(const GAS bf16x8*)(bp1 + 16 * kc); }
#pragma unroll
                for (int j = 0; j < 4; ++j) if (ks + j < per) {
                    acc[p][0] = __builtin_amdgcn_mfma_f32_32x32x16_bf16(a[j], b0[j], acc[p][0], 0, 0, 0); acc[p][1] = __builtin_amdgcn_mfma_f32_32x32x16_bf16(a[j], b1[j], acc[p][1], 0, 0, 0); } } }
#pragma unroll
        for (int p = 0; p < NP; ++p)
#pragma unroll
            for (int cb = 0; cb < 2; ++cb)
#pragma unroll
                for (int r = 0; r < 16; ++r) R[(((wid * NP + p) * 2 + cb) * 16 + r) * 64 + lane] = acc[p][cb][r];
        __syncthreads();
#pragma unroll
        for (int j = 0; j < 4; ++j) { const int idx = tid + 512 * j, cb = idx >> 10, r = (idx >> 6) & 15, ln = idx & 63; float v[NP];
#pragma unroll
            for (int p = 0; p < NP; ++p) { float s = 0.f;
#pragma unroll
                for (int w = 0; w < 8; ++w) s += R[(((w * NP + p) * 2 + cb) * 16 + r) * 64 + ln];
                v[p] = s; }
            const int row = 32 * um + crow(r, ln >> 5), col = 64 * un + 32 * cb + (ln & 31); float o = v[0];
            if (MODE == 1) { const GAS bf16_t* Zsg = (const GAS bf16_t*)Zs; const float ga = bf2f(Zsg[(size_t)row * ZP + GA_OFF + col]), gb = bf2f(Zsg[(size_t)row * ZP + GB_OFF + col]); o = pg8::fast_sigmoid(ga) * v[0] + pg8::fast_sigmoid(gb) * v[NP - 1]; }
            ((GAS bf16_t*)O)[(size_t)row * ldo + col] = (bf16_t)f2bf(o); }
        __syncthreads();
    }
}

__device__ __forceinline__ void rownorm_phase(const float* xinP, const float* xinS, float* xout, const bf16_t* Y, const float* ga, float cy, const float* gb, bf16_t* H, int gw, int NGW, int lane) {
    for (int m0 = gw; m0 < MALL; m0 += 2 * NGW) {
        int mr[2]; mr[0] = m0; mr[1] = (m0 + NGW < MALL) ? m0 + NGW : m0;
        f32x4 v[2][4]; u32x2 yw[2][4];
#pragma unroll
        for (int u = 0; u < 2; ++u) { const int m = mr[u]; const float* xr = (m < MP) ? xinP + (size_t)m * DM : xinS + (size_t)(m - MP) * DM;
#pragma unroll
            for (int j = 0; j < 4; ++j) v[u][j] = *(const GAS f32x4*)(xr + 4 * lane + 256 * j);
            if (Y) {
#pragma unroll
                for (int j = 0; j < 4; ++j) yw[u][j] = *(const GAS u32x2*)(Y + (size_t)m * DM + 4 * lane + 256 * j); } }
#pragma unroll
        for (int u = 0; u < 2; ++u) { const int m = mr[u];
            if (Y) {
                f32x4 y[4]; float s = 0.f;
#pragma unroll
                for (int j = 0; j < 4; ++j) { const u32x2 w = yw[u][j];
                    y[j][0] = __uint_as_float(w.x << 16); y[j][1] = __uint_as_float(w.x & 0xffff0000u); y[j][2] = __uint_as_float(w.y << 16); y[j][3] = __uint_as_float(w.y & 0xffff0000u);
                    s += (y[j][0] * y[j][0] + y[j][1] * y[j][1]) + (y[j][2] * y[j][2] + y[j][3] * y[j][3]); }
                const float rstd = cy * __builtin_amdgcn_rsqf(wave_sum(s) * (1.f / DM) + 1e-6f);
#pragma unroll
                for (int j = 0; j < 4; ++j) { const f32x4 g = *(const GAS f32x4*)(ga + 4 * lane + 256 * j); v[u][j] = v[u][j] + y[j] * g * rstd; }
            }
#pragma unroll
            for (int j = 0; j < 4; ++j) *(GAS f32x4*)(xout + (size_t)m * DM + 4 * lane + 256 * j) = v[u][j];
            if (H) {
                float s = 0.f;
#pragma unroll
                for (int j = 0; j < 4; ++j) s += (v[u][j][0] * v[u][j][0] + v[u][j][1] * v[u][j][1]) + (v[u][j][2] * v[u][j][2] + v[u][j][3] * v[u][j][3]);
                const float rstd = __builtin_amdgcn_rsqf(wave_sum(s) * (1.f / DM) + 1e-6f);
#pragma unroll
                for (int j = 0; j < 4; ++j) { const f32x4 g = *(const GAS f32x4*)(gb + 4 * lane + 256 * j); const f32x4 o = v[u][j] * g * rstd;
                    u32x2 w; w.x = cvt_pk_bf16(o[0], o[1]); w.y = cvt_pk_bf16(o[2], o[3]); *(GAS u32x2*)(H + (size_t)m * DM + 4 * lane + 256 * j) = w; }
            }
        }
    }
}

__device__ __forceinline__ void attn_unit(LAS unsigned char* lds, const bf16_t* Qp, int q_pitch, int q_clamp, const bf16_t* Kp, const bf16_t* Vp, int kv_pitch, const float* Kf, const float* Vf, int NT, int last_valid,
                                          int sample, int q0, bf16_t* Op, int out_rows, float lam, const float* subg, float oscale) {
    int tid_ = threadIdx.x; asm volatile("" : "+v"(tid_));
    const int tid = tid_, lane = tid & 63, wid = __builtin_amdgcn_readfirstlane(tid >> 6), s = wid & 1, rg = wid >> 1, r32 = lane & 31, hi = lane >> 5;
    const int nt_w = sample ? (rg == 0 ? NT : 0) : (((q0 + 32 * rg) >> 6) + 1);
    bf16x8 qf[4];
    { int qrow = 32 * rg + r32; qrow = qrow < q_clamp ? qrow : q_clamp;
#pragma unroll
      for (int d0 = 0; d0 < 4; ++d0) qf[d0] = *(const GAS bf16x8*)(Qp + (size_t)qrow * q_pitch + 64 * s + 16 * d0 + 8 * hi); }
    const int key0 = tid >> 4, ch = tid & 15;
    const bf16_t* kg = Kp + (size_t)key0 * kv_pitch + ch * 8; const bf16_t* vg = Vp + (size_t)key0 * kv_pitch + ch * 8;
    const size_t g32 = (size_t)32 * kv_pitch, gtile = (size_t)64 * kv_pitch;
    const int kl0 = (ch >> 3) * 8192 + key0 * 128 + (((ch & 7) ^ ((key0 >> 1) & 7)) << 4), kl1 = kl0 + 32 * 128;
    const int vl0 = 16384 + 256 * key0 + 16 * (ch ^ (((key0 & 3) << 2) | ((key0 >> 2) & 3))), vl1 = vl0 + 8192;
    u32x4 ra[4], rb[4];
#define ATT_LOAD(R, T) do { const bf16_t* kgn_ = kg + (size_t)(T) * gtile; const bf16_t* vgn_ = vg + (size_t)(T) * gtile; \
        R[0] = *(const GAS u32x4*)kgn_; R[1] = *(const GAS u32x4*)(kgn_ + g32); R[2] = *(const GAS u32x4*)vgn_; R[3] = *(const GAS u32x4*)(vgn_ + g32); } while (0)
#define ATT_STORE(R, BUF) do { LAS unsigned char* nb_ = lds + (BUF) * 32768; *(LAS u32x4*)(nb_ + kl0) = R[0]; *(LAS u32x4*)(nb_ + kl1) = R[1]; *(LAS u32x4*)(nb_ + vl0) = R[2]; *(LAS u32x4*)(nb_ + vl1) = R[3]; } while (0)
    const int kfo = s * 8192 + r32 * 128;
    const int q4 = (lane & 15) >> 2, g1 = (lane >> 4) & 1, p = lane & 3, c2 = 2 * g1 + (p >> 1);
    const int vbase = 16384 + 256 * (4 * hi + q4) + 8 * (p & 1);
    int cx[2]; const int q464 = 64 * q4;
#pragma unroll
    for (int j = 0; j < 2; ++j) cx[j] = 16 * (c2 ^ (hi + 2 * j)) + 2048 * j;
    f32x16 o[4];
#pragma unroll
    for (int eb = 0; eb < 4; ++eb)
#pragma unroll
        for (int r = 0; r < 16; ++r) o[eb][r] = 0.f;
    float lrun = 0.f;
    f32x16 negm;
#pragma unroll
    for (int r = 0; r < 16; ++r) negm[r] = 0.f;
#define ATT_VRD(KS) do { _Pragma("unroll") for (int eb = 0; eb < 4; ++eb) { \
        vv[2 * eb] = __builtin_bit_cast(s16x4, __builtin_amdgcn_ds_read_tr16_b64_v4i16((LAS s16x4*)(base + vbase + 4096 * (KS) + cx[0] + ((64 * eb) ^ q464)))); \
        vv[2 * eb + 1] = __builtin_bit_cast(s16x4, __builtin_amdgcn_ds_read_tr16_b64_v4i16((LAS s16x4*)(base + vbase + 4096 * (KS) + cx[1] + ((64 * eb) ^ q464)))); } } while (0)
#define ATT_COMPUTE(t) do { \
        if (t < nt_w) { \
            const LAS unsigned char* base = lds + (t & 1) * 32768; \
            f32x16 sA, sB; \
            { const LAS unsigned char* kb_ = base + kfo; bf16x8 kfa_[4], kfb_[4]; \
              _Pragma("unroll") for (int d0 = 0; d0 < 4; ++d0) { const int co = (((2 * d0 + hi) ^ ((r32 >> 1) & 7)) << 4); kfa_[d0] = *(const LAS bf16x8*)(kb_ + co); kfb_[d0] = *(const LAS bf16x8*)(kb_ + 4096 + co); } \
              __builtin_amdgcn_sched_barrier(0); \
              sA = __builtin_amdgcn_mfma_f32_32x32x16_bf16(kfa_[0], qf[0], negm, 0, 0, 0); sB = __builtin_amdgcn_mfma_f32_32x32x16_bf16(kfb_[0], qf[0], negm, 0, 0, 0); \
              _Pragma("unroll") for (int d0 = 1; d0 < 4; ++d0) { sA = __builtin_amdgcn_mfma_f32_32x32x16_bf16(kfa_[d0], qf[d0], sA, 0, 0, 0); sB = __builtin_amdgcn_mfma_f32_32x32x16_bf16(kfb_[d0], qf[d0], sB, 0, 0, 0); } \
              __builtin_amdgcn_sched_barrier(0); } \
            if (t == NT - 1 && last_valid < 64) { \
                _Pragma("unroll") for (int r = 0; r < 16; ++r) { const int kv = crow(r, hi); if (kv >= last_valid) sA[r] = -INFINITY; if (kv + 32 >= last_valid) sB[r] = -INFINITY; } } \
            asm volatile("s_nop 15\n\ts_nop 7" : "+v"(sA), "+v"(sB));     \
            float rm; { float a_ = max3f(sA[0], sA[1], sB[0]), b_ = max3f(sA[2], sA[3], sB[1]); a_ = max3f(a_, sB[2], sB[3]); \
              _Pragma("unroll") for (int r = 4; r < 16; r += 4) { a_ = max3f(a_, sA[r], sA[r + 1]); b_ = max3f(b_, sA[r + 2], sA[r + 3]); a_ = max3f(a_, sB[r], sB[r + 1]); b_ = max3f(b_, sB[r + 2], sB[r + 3]); } \
              rm = fmaxf(a_, b_); } \
            rm = swap32_max(rm); \
            if (t == 0 || __any(rm > 8.0f)) { const float dl = (t == 0) ? rm : fmaxf(rm, 0.f); const float f = __builtin_amdgcn_exp2f(-dl); const float nm = negm[0] - dl; lrun *= f; \
                _Pragma("unroll") for (int eb = 0; eb < 4; ++eb) _Pragma("unroll") for (int r = 0; r < 16; ++r) o[eb][r] *= f; \
                _Pragma("unroll") for (int r = 0; r < 16; ++r) { sA[r] -= dl; sB[r] -= dl; negm[r] = nm; } } \
            _Pragma("unroll") for (int r = 0; r < 16; ++r) { sA[r] = __builtin_amdgcn_exp2f(sA[r]); sB[r] = __builtin_amdgcn_exp2f(sB[r]); } \
            asm volatile("s_nop 1" : "+v"(sA), "+v"(sB));     \
            { float l0_ = sA[0], l1_ = sB[0];     \
              _Pragma("unroll") for (int r = 1; r < 16; ++r) { l0_ = fadd_s(l0_, sA[r]); l1_ = fadd_s(l1_, sB[r]); } \
              lrun += fadd_s(l0_, l1_); } \
            u32x4 pw[4]; \
            _Pragma("unroll") for (int i = 0; i < 4; ++i) { pw[0][i] = cvt_pk_bf16(sA[2 * i], sA[2 * i + 1]); pw[1][i] = cvt_pk_bf16(sA[8 + 2 * i], sA[9 + 2 * i]); pw[2][i] = cvt_pk_bf16(sB[2 * i], sB[2 * i + 1]); pw[3][i] = cvt_pk_bf16(sB[8 + 2 * i], sB[9 + 2 * i]); } \
            s16x4 vv[8]; \
            _Pragma("unroll") for (int ks = 0; ks < 4; ++ks) { const bf16x8 pf = __builtin_bit_cast(bf16x8, pw[ks]); \
                ATT_VRD(ks); \
                __builtin_amdgcn_sched_barrier(0); \
                _Pragma("unroll") for (int eb = 0; eb < 4; ++eb) { const s16x4 lo = vv[2 * eb], hh = vv[2 * eb + 1]; \
                    const bf16x8 vf = {lo[0], lo[1], lo[2], lo[3], hh[0], hh[1], hh[2], hh[3]}; \
                    o[eb] = __builtin_amdgcn_mfma_f32_32x32x16_bf16(vf, pf, o[eb], 0, 0, 0); } \
                __builtin_amdgcn_sched_barrier(0); } \
        } \
        } while (0)
#define ATT_STEP(RW, RN, T) do { const int t_ = (T); \
        if (t_ + 2 < NT) ATT_LOAD(RN, t_ + 2); \
        ATT_COMPUTE(t_); \
        if (t_ + 1 < NT) ATT_STORE(RW, (t_ + 1) & 1); \
        __syncthreads(); } while (0)
    if (!sample) {
        ATT_LOAD(ra, 0);
        if (NT > 1) ATT_LOAD(rb, 1);
        ATT_STORE(ra, 0);
        __syncthreads();
        int tt = 0;
        for (; tt + 1 < NT; tt += 2) { ATT_STEP(rb, ra, tt); ATT_STEP(ra, rb, tt + 1); }
        if (tt < NT) ATT_STEP(rb, ra, tt);
    } else {
        const float* kfp = Kf + (size_t)key0 * 512 + ch * 8; const float* vfp = Vf + (size_t)key0 * 512 + ch * 8;
#define ATT_LOADF(T) do { const float* kfn_ = kfp + (size_t)(T) * 32768; const float* vfn_ = vfp + (size_t)(T) * 32768; \
            ra[0] = *(const GAS u32x4*)kfn_; ra[1] = *(const GAS u32x4*)(kfn_ + 4); ra[2] = *(const GAS u32x4*)(kfn_ + 16384); ra[3] = *(const GAS u32x4*)(kfn_ + 16388); \
            rb[0] = *(const GAS u32x4*)vfn_; rb[1] = *(const GAS u32x4*)(vfn_ + 4); rb[2] = *(const GAS u32x4*)(vfn_ + 16384); rb[3] = *(const GAS u32x4*)(vfn_ + 16388); } while (0)
#define ATT_F4(x) __builtin_bit_cast(f32x4, x)
#define ATT_STOREF(BUF) do { LAS unsigned char* nb_ = lds + (BUF) * 32768; \
            *(LAS u32x4*)(nb_ + kl0) = pg8::pack8(ATT_F4(ra[0]), ATT_F4(ra[1])); *(LAS u32x4*)(nb_ + kl1) = pg8::pack8(ATT_F4(ra[2]), ATT_F4(ra[3])); \
            *(LAS u32x4*)(nb_ + vl0) = pg8::pack8(ATT_F4(rb[0]), ATT_F4(rb[1])); *(LAS u32x4*)(nb_ + vl1) = pg8::pack8(ATT_F4(rb[2]), ATT_F4(rb[3])); } while (0)
        ATT_LOADF(0); ATT_STOREF(0);
        __syncthreads();
        for (int ts = 0; ts < NT; ++ts) {
            if (ts + 2 < NT) ATT_LOADF(ts + 1); else if (ts + 1 < NT) ATT_LOAD(ra, ts + 1);
            ATT_COMPUTE(ts);
            if (ts + 2 < NT) ATT_STOREF((ts + 1) & 1); else if (ts + 1 < NT) ATT_STORE(ra, (ts + 1) & 1);
            __syncthreads();
        }
#undef ATT_LOADF
#undef ATT_F4
#undef ATT_STOREF
    }
#undef ATT_COMPUTE
#undef ATT_LOAD
#undef ATT_STORE
#undef ATT_VRD
#undef ATT_STEP
    const float lt = swap32_add(lrun); const float inv = __builtin_amdgcn_rcpf(lt);
    LAS float* X = (LAS float*)(lds + 65536 + rg * 16384);
    if (s == 1 && nt_w > 0) {
#pragma unroll
        for (int eb = 0; eb < 4; ++eb)
#pragma unroll
            for (int r = 0; r < 16; ++r) X[(eb * 16 + r) * 64 + lane] = o[eb][r] * inv;
    }
    __syncthreads();
    if (s == 0 && nt_w > 0) {
        float ss = 0.f;
#pragma unroll
        for (int eb = 0; eb < 4; ++eb)
#pragma unroll
            for (int r = 0; r < 16; ++r) { const float v = o[eb][r] * inv - lam * X[(eb * 16 + r) * 64 + lane]; o[eb][r] = v; ss += v * v; }
        ss = swap32_add(ss);
        const float rstd = __builtin_amdgcn_rsqf(ss * (1.f / 128.f) + 1e-5f) * oscale;
        const int row = 32 * rg + r32;
        if (row < out_rows) {
#pragma unroll
            for (int eb = 0; eb < 4; ++eb)
#pragma unroll
                for (int g4 = 0; g4 < 4; ++g4) { const int e = 32 * eb + 8 * g4 + 4 * hi; const f32x4 g = *(const GAS f32x4*)(subg + e);
                    u32x2 w; w.x = cvt_pk_bf16(o[eb][4 * g4] * rstd * g[0], o[eb][4 * g4 + 1] * rstd * g[1]); w.y = cvt_pk_bf16(o[eb][4 * g4 + 2] * rstd * g[2], o[eb][4 * g4 + 3] * rstd * g[3]);
                    *(GAS u32x2*)(Op + (size_t)row * OP + e) = w; }
        }
    }
    __syncthreads();
}

constexpr int G_LA = 0, G_ALR = 16640, G_WG = G_ALR + 4096, G_BG = G_WG + 4096, G_SEG = G_BG + 256, G_KE = G_SEG + 2048, G_KDT = G_KE + 9216, G_QE = G_KDT + 9216, G_ATT = G_QE + 9216, G_VT = G_ATT + 9216, G_ST = G_VT + 18432, G_END = G_ST + 18432;
static_assert(G_KDT >= 64 * 132 * 4, "OBUF aliases LA..KE");
static_assert(G_END <= LDS_MAIN, "gla lds");
template <int MODE> __device__ __forceinline__ void gla_unit(LAS unsigned char* lds, const bf16_t* Zr, int ntok, const float* wgu, const float* bgp, int h, float* ds_out, float* dec_out,
                                                              const float* Sprev, float* sfin, const float* glang, bf16_t* Oout) {
    int tid_ = threadIdx.x; asm volatile("" : "+v"(tid_));
    const int tid = tid_, lane = tid & 63, wid = __builtin_amdgcn_readfirstlane(tid >> 6), r32 = lane & 31, hi = lane >> 5;
    const GAS bf16_t* Zg = (const GAS bf16_t*)Zr; const GAS float* wgu_g = (const GAS float*)wgu; const GAS float* bg_g = (const GAS float*)bgp; const GAS float* Sp_g = (const GAS float*)Sprev;
    GAS float* ds_g = (GAS float*)ds_out; GAS float* dec_g = (GAS float*)dec_out; GAS float* sf_g = (GAS float*)sfin; const GAS float* gl_g = (const GAS float*)glang;
    const int pt = tid >> 3, pd8 = (tid & 7) * 8, vt0 = tid >> 4, vc8 = (tid & 15) * 8;
    u32x4 qw = {0u, 0u, 0u, 0u}, kw = qw, vw0 = qw, vw1 = qw, rw0 = qw, rw1 = qw; f32x4 sw[4];
    if (pt < ntok) { qw = *(const GAS u32x4*)(Zg + (size_t)pt * ZP + QB_OFF + 64 * h + pd8); kw = *(const GAS u32x4*)(Zg + (size_t)pt * ZP + KB_OFF + 64 * h + pd8); }
    if (vt0 < ntok) vw0 = *(const GAS u32x4*)(Zg + (size_t)vt0 * ZP + VB_OFF + 128 * h + vc8);
    if (vt0 + 32 < ntok) vw1 = *(const GAS u32x4*)(Zg + (size_t)(vt0 + 32) * ZP + VB_OFF + 128 * h + vc8);
    if (MODE != 0) {
#pragma unroll
        for (int j = 0; j < 4; ++j) { const int idx = tid + 512 * j; sw[j] = *(const GAS f32x4*)(Sp_g + (idx >> 5) * 128 + (idx & 31) * 4); }
        if (pt < ntok) { const GAS bf16_t* rbp = Zg + (size_t)pt * ZP + RB_OFF + 128 * h + 16 * (tid & 7); rw0 = *(const GAS u32x4*)rbp; rw1 = *(const GAS u32x4*)(rbp + 8); }
    }
    LAS float* LA = (LAS float*)(lds + G_LA); LAS float* ALR = (LAS float*)(lds + G_ALR); LAS float* WG = (LAS float*)(lds + G_WG); LAS float* BG = (LAS float*)(lds + G_BG); LAS float* SEG = (LAS float*)(lds + G_SEG);
    LAS bf16_t* KE = (LAS bf16_t*)(lds + G_KE); LAS bf16_t* KDT = (LAS bf16_t*)(lds + G_KDT); LAS bf16_t* QE = (LAS bf16_t*)(lds + G_QE); LAS bf16_t* ATT = (LAS bf16_t*)(lds + G_ATT);
    LAS bf16_t* VT = (LAS bf16_t*)(lds + G_VT); LAS bf16_t* ST = (LAS bf16_t*)(lds + G_ST); LAS float* OB = (LAS float*)(lds + 0);
#pragma unroll
    for (int j = 0; j < 2; ++j) { const int e = tid + 512 * j, t = e >> 4, r = e & 15; ALR[e] = (t < ntok) ? bf2f(Zg[(size_t)t * ZP + ALR_OFF + r]) : 0.f;
        const int rr = e >> 6, d = e & 63; WG[e] = wgu_g[rr * 256 + 64 * h + d]; }
    if (tid < 64) BG[tid] = bg_g[64 * h + tid];
    __syncthreads();
#pragma unroll
    for (int j = 0; j < 8; ++j) { const int e = tid + 512 * j, t = e >> 6, d = e & 63; float x = BG[d];
#pragma unroll
        for (int r = 0; r < 16; ++r) x += ALR[t * 16 + r] * WG[r * 64 + d];
        const float ls = fminf(x, 0.f) - __logf(1.f + __expf(-fabsf(x)));
        LA[t * 65 + d] = (t < ntok) ? ls * (1.f / 16.f) : 0.f; }
    __syncthreads();
    { const int d = tid & 63, sg = tid >> 6; float run = 0.f;
#pragma unroll
      for (int i = 0; i < 8; ++i) { run += LA[(8 * sg + i) * 65 + d]; LA[(8 * sg + i) * 65 + d] = run; }
      SEG[sg * 64 + d] = run;
      __syncthreads();
      float pre = 0.f;
#pragma unroll
      for (int q = 0; q < 8; ++q) pre += (q < sg) ? SEG[q * 64 + d] : 0.f;
#pragma unroll
      for (int i = 0; i < 8; ++i) LA[(8 * sg + i) * 65 + d] += pre; }
    __syncthreads();
    { f32x4 q0, q1, k0, k1; pg8::unpack8(qw, q0, q1); pg8::unpack8(kw, k0, k1); f32x4 e0, e1, f0, f1;
#pragma unroll
      for (int i = 0; i < 8; ++i) { const int d = pd8 + i; const float b = LA[pt * 65 + d], bl = LA[63 * 65 + d]; const float q = (i < 4) ? q0[i & 3] : q1[i & 3], k = (i < 4) ? k0[i & 3] : k1[i & 3];
          const float qe = q * __expf(b), ke = k * __expf(-b); if (i < 4) { e0[i & 3] = qe; f0[i & 3] = ke; } else { e1[i & 3] = qe; f1[i & 3] = ke; }
          KDT[d * 72 + pt] = (bf16_t)f2bf(k * __expf(bl - b)); }
      *(LAS u32x4*)(QE + pt * 72 + pd8) = pg8::pack8(e0, e1); *(LAS u32x4*)(KE + pt * 72 + pd8) = pg8::pack8(f0, f1); }
#pragma unroll
    for (int i = 0; i < 4; ++i) { const unsigned a0 = vw0[i], a1 = vw1[i];
        VT[(vc8 + 2 * i) * 72 + vt0] = (bf16_t)(a0 & 0xffffu); VT[(vc8 + 2 * i + 1) * 72 + vt0] = (bf16_t)(a0 >> 16);
        VT[(vc8 + 2 * i) * 72 + vt0 + 32] = (bf16_t)(a1 & 0xffffu); VT[(vc8 + 2 * i + 1) * 72 + vt0 + 32] = (bf16_t)(a1 >> 16); }
    if (MODE != 0) {
#pragma unroll
        for (int j = 0; j < 4; ++j) { const int idx = tid + 512 * j, d = idx >> 5, c4 = (idx & 31) * 4;
#pragma unroll
            for (int i = 0; i < 4; ++i) ST[(c4 + i) * 72 + d] = (bf16_t)f2bf(sw[j][i]); }
    }
    if (MODE == 0 && tid < 64) dec_g[tid] = __expf(LA[63 * 65 + tid]);
    __syncthreads();
    if (MODE != 1) { const int mb = wid >> 2, nb = wid & 3; f32x16 acc;
#pragma unroll
        for (int r = 0; r < 16; ++r) acc[r] = 0.f;
#pragma unroll
        for (int ks = 0; ks < 4; ++ks) { const bf16x8 a = *(const LAS bf16x8*)(KDT + (32 * mb + r32) * 72 + 16 * ks + 8 * hi), b = *(const LAS bf16x8*)(VT + (32 * nb + r32) * 72 + 16 * ks + 8 * hi);
            acc = __builtin_amdgcn_mfma_f32_32x32x16_bf16(a, b, acc, 0, 0, 0); }
#pragma unroll
        for (int r = 0; r < 16; ++r) { const int d = 32 * mb + crow(r, hi), e = 32 * nb + r32;
            if (MODE == 0) ds_g[d * 128 + e] = acc[r];
            else sf_g[d * 128 + e] = __expf(LA[63 * 65 + d]) * Sp_g[d * 128 + e] + acc[r]; }
    }
    if (MODE != 0) {
        if (wid < 4) { const int ib = wid >> 1, jb = wid & 1; f32x16 acc;
#pragma unroll
            for (int r = 0; r < 16; ++r) acc[r] = 0.f;
#pragma unroll
            for (int ks = 0; ks < 4; ++ks) { const bf16x8 a = *(const LAS bf16x8*)(QE + (32 * ib + r32) * 72 + 16 * ks + 8 * hi), b = *(const LAS bf16x8*)(KE + (32 * jb + r32) * 72 + 16 * ks + 8 * hi);
                acc = __builtin_amdgcn_mfma_f32_32x32x16_bf16(a, b, acc, 0, 0, 0); }
#pragma unroll
            for (int r = 0; r < 16; ++r) { const int i = 32 * ib + crow(r, hi), jj = 32 * jb + r32; ATT[i * 72 + jj] = (bf16_t)f2bf(jj <= i ? acc[r] : 0.f); }
        }
        __syncthreads();
        { const int ib = wid >> 2, eb = wid & 3; f32x16 acc;
#pragma unroll
          for (int r = 0; r < 16; ++r) acc[r] = 0.f;
#pragma unroll
          for (int ks = 0; ks < 4; ++ks) { const bf16x8 a = *(const LAS bf16x8*)(ATT + (32 * ib + r32) * 72 + 16 * ks + 8 * hi), b = *(const LAS bf16x8*)(VT + (32 * eb + r32) * 72 + 16 * ks + 8 * hi);
              acc = __builtin_amdgcn_mfma_f32_32x32x16_bf16(a, b, acc, 0, 0, 0); }
#pragma unroll
          for (int ks = 0; ks < 4; ++ks) { const bf16x8 a = *(const LAS bf16x8*)(QE + (32 * ib + r32) * 72 + 16 * ks + 8 * hi), b = *(const LAS bf16x8*)(ST + (32 * eb + r32) * 72 + 16 * ks + 8 * hi);
              acc = __builtin_amdgcn_mfma_f32_32x32x16_bf16(a, b, acc, 0, 0, 0); }
#pragma unroll
          for (int r = 0; r < 16; ++r) OB[(32 * ib + crow(r, hi)) * 132 + 32 * eb + r32] = acc[r];
        }
        __syncthreads();
        { const int i = tid >> 3, sg = tid & 7; float v[16]; float ss = 0.f;
#pragma unroll
          for (int c = 0; c < 16; ++c) { v[c] = OB[i * 132 + 16 * sg + c]; ss += v[c] * v[c]; }
          ss += __shfl_xor(ss, 1); ss += __shfl_xor(ss, 2); ss += __shfl_xor(ss, 4);
          const float rstd = __builtin_amdgcn_rsqf(ss * (1.f / 128.f) + 1e-5f);
          if (i < ntok) {
#pragma unroll
              for (int hh = 0; hh < 2; ++hh) { const u32x4 rw = hh ? rw1 : rw0; f32x4 r0, r1; pg8::unpack8(rw, r0, r1); f32x4 o0, o1;
#pragma unroll
                  for (int c = 0; c < 4; ++c) { const float g0 = gl_g[16 * sg + 8 * hh + c], g1 = gl_g[16 * sg + 8 * hh + 4 + c];
                      o0[c] = v[8 * hh + c] * rstd * g0 * r0[c] * pg8::fast_sigmoid(r0[c]); o1[c] = v[8 * hh + 4 + c] * rstd * g1 * r1[c] * pg8::fast_sigmoid(r1[c]); }
                  *(GAS u32x4*)(Oout + (size_t)i * OP + 16 * sg + 8 * hh) = pg8::pack8(o0, o1); } }
        }
    }
    __syncthreads();
}

__device__ __forceinline__ unsigned char* opq(unsigned char* p) { asm volatile("" : "+s"(p)); return p; }
__device__ __forceinline__ float* opqf(float* p) { asm volatile("" : "+s"(p)); return p; }
#define XB_TMO      128
#define XB_XCNT(j)  (256  + 64 * (j))
#define XB_XSUB(j)  (1280 + 64 * (j))
#define XB_XGEN(j)  (2304 + 64 * (j))
#define XB_TOP      3328
#define XB_TOPGEN   3392
#define XCD_BAR_WORDS 3456
#define XB_SPIN_CAP (1u << 18)

__device__ __forceinline__ unsigned xb_ld(unsigned* p)              { return __hip_atomic_load(p, __ATOMIC_RELAXED, __HIP_MEMORY_SCOPE_AGENT); }
__device__ __forceinline__ unsigned xb_add(unsigned* p, unsigned v) { return __hip_atomic_fetch_add(p, v, __ATOMIC_RELAXED, __HIP_MEMORY_SCOPE_AGENT); }
__device__ __forceinline__ unsigned xb_xcc_id() { return (unsigned)__builtin_amdgcn_s_getreg((3 << 11) | 20) & 0xFu; }
#define XB_SPIN(cond, bar) do { unsigned _sp = 0; while (cond) { __builtin_amdgcn_s_sleep(1); \
    if ((++_sp & 255u) == 0u) { if (xb_ld(&(bar)[XB_TMO])) break; if (_sp > XB_SPIN_CAP) { atomicAdd(&(bar)[XB_TMO], 1u); break; } } } } while (0)

struct XcdBarrier {
    unsigned* bar; unsigned x;
    volatile LAS unsigned* st;
};

__device__ __forceinline__ XcdBarrier xcd_barrier_post(unsigned* bar, volatile LAS unsigned* st) {
    XcdBarrier b; b.bar = bar; b.x = xb_xcc_id(); b.st = st;
    if (threadIdx.x == 0) (void)xb_add(&bar[XB_XCNT(b.x)], 1u);
    return b;
}
__device__ __forceinline__ void xcd_barrier_complete(unsigned* bar, unsigned x, unsigned& nloc, unsigned& nx) {
    const unsigned G = gridDim.x * gridDim.y * gridDim.z;
    unsigned sum, cnt, mine, sp = 0u;
    for (;;) {
        sum = 0u; cnt = 0u; mine = 0u;
#pragma unroll
        for (unsigned j = 0; j < 16; ++j) { const unsigned c = xb_ld(&bar[XB_XCNT(j)]); sum += c; cnt += (c > 0u) ? 1u : 0u; mine = (j == x) ? c : mine; }
        if (sum == G) break;
        __builtin_amdgcn_s_sleep(1);
        if ((++sp & 255u) == 0u) { if (xb_ld(&bar[XB_TMO])) break; if (sp > XB_SPIN_CAP) { atomicAdd(&bar[XB_TMO], 1u); break; } }
    }
    nloc = mine > 0u ? mine : 1u; nx = cnt > 0u ? cnt : 1u;
}

__device__ __forceinline__ void xcd_barrier(const XcdBarrier& b) {
    asm volatile("s_waitcnt vmcnt(0)" ::: "memory");
    __syncthreads();
    if (threadIdx.x == 0) {
        unsigned* bar = b.bar;
        __builtin_amdgcn_s_waitcnt(0);
        unsigned nloc = b.st[0], nx = b.st[1];
        if (nloc == 0u) { xcd_barrier_complete(bar, b.x, nloc, nx); b.st[0] = nloc; b.st[1] = nx; }
        const unsigned old = xb_add(&bar[XB_XSUB(b.x)], 1u);
        const unsigned gen = old / nloc;
        if (old + 1u == (gen + 1u) * nloc) {
            __builtin_amdgcn_fence(__ATOMIC_RELEASE, "agent");
            asm volatile("s_waitcnt vmcnt(0)" ::: "memory");
            const unsigned og = xb_add(&bar[XB_TOP], 1u);
            const unsigned tg = og / nx;
            if (og + 1u == (tg + 1u) * nx) xb_add(&bar[XB_TOPGEN], 1u);
            else XB_SPIN(xb_ld(&bar[XB_TOPGEN]) == tg, bar);
            __builtin_amdgcn_fence(__ATOMIC_ACQUIRE, "agent");
            xb_add(&bar[XB_XGEN(b.x)], 1u);
            asm volatile("s_waitcnt vmcnt(0)" ::: "memory");
        } else {
            XB_SPIN(xb_ld(&bar[XB_XGEN(b.x)]) == gen, bar);
            __builtin_amdgcn_fence(__ATOMIC_ACQUIRE, "agent");
            asm volatile("s_waitcnt vmcnt(0)" ::: "memory");
        }
    }
    __syncthreads();
}

template <class Epi> __device__ __forceinline__ void run_gemm(LAS unsigned char* lds, const bf16_t* A, const bf16_t* Bt, int M, int N, int K, const Epi& E) {
    pg8::Gemm g{A, Bt, M, N, K}; pg8::StaticOrder S; S.init(M, N, (int)gridDim.x, (int)blockIdx.x);
    pg8::gemm_phase<Epi, pg8::StaticOrder, true, true>(lds, g, S, E);
}

constexpr float QSCALE = 0.125f * 1.4426950408889634f;

__global__ void __launch_bounds__(512, 2) mega_fwd(Params P) {
    extern __shared__ __attribute__((aligned(16))) unsigned char lds_raw[];
    LAS unsigned char* lds = (LAS unsigned char*)lds_raw;
    cg::grid_group grid = cg::this_grid();
    int tid = threadIdx.x; asm volatile("" : "+v"(tid)); int lane = tid & 63, wid = __builtin_amdgcn_readfirstlane(tid >> 6);
    const int G = gridDim.x, bid = blockIdx.x, NGW = G * 8; int gw = bid * 8 + wid;
    unsigned char* wsl = opq(P.ws); float* outl = opqf(P.out);
#define NEWPHASE() do { wsl = opq(P.ws); outl = opqf(P.out); tid = threadIdx.x; asm volatile("" : "+v"(tid)); lane = tid & 63; wid = __builtin_amdgcn_readfirstlane(tid >> 6); gw = bid * 8 + wid; } while (0)
#define WSB() wsl
#define GSYNC() do { XcdBarrier b_; b_.bar = (unsigned*)(opq(P.ws) + W_CTR) + 1024; b_.x = xb_xcc_id(); b_.st = (volatile LAS unsigned*)(misc + 8); xcd_barrier(b_); NEWPHASE(); } while (0)
#define PB(off) ((bf16_t*)(WSB() + (off)))
#define PF(off) ((float*)(WSB() + (off)))
#define ctr ((unsigned*)(WSB() + W_CTR))
#define WGU PB(W_WGU)
#define WD PB(W_WD)
#define WIN PB(W_WIN)
#define WOA PB(W_WOA)
#define WOB PB(W_WOB)
#define WO PB(W_WO)
#define H PB(W_H)
#define ACT PB(W_ACT)
#define Y PB(W_Y)
#define Z PB(W_Z)
#define OA PB(W_OAB)
#define OB (PB(W_OAB) + (size_t)MALL * OP)
#define MIX PB(W_MIX)
#define KC PB(W_KC)
#define VC PB(W_VC)
#define DS PF(W_DS)
#define DEC PF(W_DEC)
#define ropec PF(W_ROPE)
#define ropes (PF(W_ROPE) + (size_t)MP * 32)
#define xbuf outl
    LAS unsigned* misc = (LAS unsigned*)(lds + LDS_MAIN);
    if (threadIdx.x < 4) misc[8 + threadIdx.x] = 0u;
    __syncthreads();
    (void)xcd_barrier_post((unsigned*)(P.ws + W_CTR) + 1024, (volatile LAS unsigned*)(misc + 8));
    grid.sync();

    { LAS float* finv = (LAS float*)(lds + LDS_MAIN + 256);
#pragma unroll
      for (int d = 0; d < 32; ++d) if (tid == d) finv[d] = P.inv_freq[d];
      __syncthreads();
      for (int idx = bid * 512 + tid; idx < MP * 32; idx += G * 512) { const int pos = idx >> 5, d = idx & 31; const float ang = (float)pos * finv[d];
          double rev = (double)ang * 0.15915494309189535; rev -= floor(rev); const float fr = (float)rev;
          ropec[idx] = __builtin_amdgcn_cosf(fr); ropes[idx] = __builtin_amdgcn_sinf(fr); }
      __syncthreads();
    }
    { LAS float* scr = (LAS float*)(lds + wid * 8448);
      for (int it = gw; it < 24320; it += NGW) { int r = it;
          if (r < 16896) { const int lf = r / 4224; r -= lf * 4224;
              if (r < 2816) transpose_item(P.w_gate + (size_t)lf * DM * DFF, P.w_up + (size_t)lf * DM * DFF, DFF, DM, 1, WGU + (size_t)lf * NGU * DM, scr, r, 176, lane);
              else transpose_item(P.w_down + (size_t)lf * DFF * DM, nullptr, DM, DFF, 0, WD + (size_t)lf * DM * DFF, scr, r - 2816, 32, lane);
          } else { r -= 16896; const int l = r / 3712; r -= l * 3712;
              if (r < 2688) transpose_item(P.w_in + (size_t)l * DM * 5136, nullptr, 5136, DM, 2, WIN + (size_t)l * ZP * DM, scr, r, 168, lane);
              else if (r < 2944) transpose_item(P.w_out_a + (size_t)l * 512 * DM, nullptr, DM, 512, 0, WOA + (size_t)l * DM * 512, scr, r - 2688, 32, lane);
              else if (r < 3200) transpose_item(P.w_out_b + (size_t)l * 512 * DM, nullptr, DM, 512, 0, WOB + (size_t)l * DM * 512, scr, r - 2944, 32, lane);
              else transpose_item(P.w_out + (size_t)l * DM * DM, nullptr, DM, DM, 0, WO + (size_t)l * DM * DM, scr, r - 3200, 32, lane); } }
    }
    rownorm_phase(P.x_prompt, P.x_sample, xbuf, nullptr, nullptr, 0.f, P.norm_g, H, gw, NGW, lane);
    GSYNC();

#pragma unroll
    for (int l = 0; l < 2; ++l) {
        const float* ng = P.norm_g + (size_t)l * 6 * DM;
        run_gemm(lds, H, WGU + (size_t)(l * 2) * NGU * DM, MALL, NGU, DM, pg8::EpiSwiGLU{ACT, DFF});
        GSYNC();
        run_gemm(lds, ACT, WD + (size_t)(l * 2) * DM * DFF, MP, DM, DFF, pg8::EpiPlain{Y, DM});
        gemm_small<0>(lds, ACT + (size_t)MP * DFF, WD + (size_t)(l * 2) * DM * DFF, DFF, nullptr, nullptr, 0, Y + (size_t)MP * DM, DM, nullptr);
        GSYNC();
        rownorm_phase(xbuf, xbuf + (size_t)MP * DM, xbuf, Y, ng + 1 * DM, 0.5f, ng + 2 * DM, H, gw, NGW, lane);
        GSYNC();
        {

                { pg8::EpiInProj E{Z, ZP, ropec, ropes, P.out + O_KP + (size_t)l * MP * 512, P.out + O_VP + (size_t)l * MP * 512, P.out + O_KS + (size_t)l * MS * 512, P.out + O_VS + (size_t)l * MS * 512,
                                   KC + (size_t)l * 32 * KCROWS * 512, VC + (size_t)l * 32 * KCROWS * 512, QSCALE};
                  run_gemm(lds, H, WIN + (size_t)l * ZP * DM, MALL, ZP, DM, E); }
                GSYNC();
#if defined(STOP_AT) && STOP_AT == 2
                return;
#endif
                const float* wgu = P.w_gate_up + (size_t)l * 16 * 256; const float* bgp = P.b_gate + (size_t)l * 256;
                for (int u = bid; u < NCHUNK * 4; u += G) { const int n = u >> 2, h = u & 3;
                    gla_unit<0>(lds, Z + (size_t)(64 * n) * ZP, 64, wgu, bgp, h, DS + (size_t)u * 8192, DEC + (size_t)u * 64, nullptr, nullptr, nullptr, nullptr); }
                GSYNC();
                { LAS float* SA = (LAS float*)lds; LAS float* SBv = SA + 512; const int el = tid & 127, sg = tid >> 7;
                  for (int base = bid * 128; base < 32768; base += G * 128) { const int gid = base + el, hd = gid >> 7, e = gid & 127;
                    GAS float* dsp = (GAS float*)(DS + (size_t)hd * 128 + e + (size_t)(64 * sg) * 32768); const GAS float* dcp = (const GAS float*)(DEC + hd + (64 * sg) * 256);
                    float A = 1.f, B = 0.f;
                    for (int n = 0; n < 64; n += 16) { float v[16], c[16];
#pragma unroll
                        for (int j = 0; j < 16; ++j) { v[j] = dsp[(size_t)(n + j) * 32768]; c[j] = dcp[(n + j) * 256]; }
#pragma unroll
                        for (int j = 0; j < 16; ++j) { B = c[j] * B + v[j]; A *= c[j]; } }
                    SA[sg * 128 + el] = A; SBv[sg * 128 + el] = B;
                    __syncthreads();
                    float S = 0.f;
#pragma unroll
                    for (int q = 0; q < 3; ++q) if (q < sg) S = SA[q * 128 + el] * S + SBv[q * 128 + el];
                    for (int n = 0; n < 64; n += 16) { float v[16], c[16];
#pragma unroll
                        for (int j = 0; j < 16; ++j) { v[j] = dsp[(size_t)(n + j) * 32768]; c[j] = dcp[(n + j) * 256]; }
#pragma unroll
                        for (int j = 0; j < 16; ++j) { const float prev = S; S = c[j] * S + v[j]; dsp[(size_t)(n + j) * 32768] = prev; } }
                    if (sg == 3) P.out[O_SP + (size_t)l * 32768 + gid] = S;
                    __syncthreads(); } }
                GSYNC();
                { int lq = l; asm volatile("" : "+s"(lq)); const float lam_init = (lq == 0) ? 0.2f : 0.35550906f; const float* lf = P.lambda_p + (size_t)l * 256;
                  const float lam_v = __expf(wave_sum(lf[lane] * lf[64 + lane])) - __expf(wave_sum(lf[128 + lane] * lf[192 + lane])) + lam_init;
                  const float lam = __uint_as_float(__builtin_amdgcn_readfirstlane(__float_as_uint(lam_v)));
                  const float osc = __uint_as_float(__builtin_amdgcn_readfirstlane(__float_as_uint(1.f - lam_init)));
                  const float* subg = P.subln_g + (size_t)l * 128; const float* glang = P.gla_norm_g + (size_t)l * 128;
                  const bf16_t* KCl = KC + (size_t)l * 32 * KCROWS * 512; const bf16_t* VCl = VC + (size_t)l * 32 * KCROWS * 512;
                  const unsigned hq0 = xb_xcc_id() & 3u; unsigned exh = 0u;
                  for (;;) {
                      if (tid == 0) { unsigned code = 0xffffffffu;
                          for (unsigned kq = 0; kq < 4u && code == 0xffffffffu; ++kq) { const unsigned hh = (hq0 + kq) & 3u;
                              if (!((exh >> hh) & 1u)) { const unsigned idx = atomicAdd(&ctr[l * 16 + hh], 1u); if (idx < 160u) code = (idx < 112u) ? ((127u - idx) * 4u + hh) : (idx < 144u) ? (512u + (idx - 112u) * 4u + hh) : ((15u - (idx - 144u)) * 4u + hh); else exh |= 1u << hh; } }
                          if (code == 0xffffffffu) { const unsigned idx = atomicAdd(&ctr[l * 16 + 4], 1u); if (idx < 1152u) code = 640u + idx; }
                          misc[0] = code; }
                      __syncthreads();
                      const unsigned u = misc[0];
                      __syncthreads();
                      if (u == 0xffffffffu) break;
                      if (u < 640u) {
#ifndef SKIP_ATTN
                          int smp = 0, qb = 0, h = (int)(u & 3), b = 0;
                          if (u < 512u) qb = (int)(u >> 2); else { smp = 1; b = (int)((u - 512u) >> 2); }
                          if (!smp) { const int q0 = 128 * qb;
                              attn_unit(lds, Z + (size_t)q0 * ZP + QA_OFF + 128 * h, ZP, 127, Z + KA_OFF + 128 * h, Z + VA_OFF + 128 * h, ZP, nullptr, nullptr, 2 * qb + 2, 64, 0, q0, OA + (size_t)q0 * OP + 128 * h, 128, lam, subg, osc);
                          } else { const int R0 = MP + 16 * b;
                              attn_unit(lds, Z + (size_t)R0 * ZP + QA_OFF + 128 * h, ZP, 15, KCl + (size_t)b * KCROWS * 512 + 128 * h, VCl + (size_t)b * KCROWS * 512 + 128 * h, 512, P.cache_k + ((size_t)(l * 32 + b) * PAST) * 512 + 128 * h, P.cache_v + ((size_t)(l * 32 + b) * PAST) * 512 + 128 * h, 33, 16, 1, 0, OA + (size_t)R0 * OP + 128 * h, 16, lam, subg, osc); }
#endif
                      } else if (u < 1664u) { const int v = (int)u - 640, n = v >> 2, h = v & 3;
#ifndef SKIP_GLA12
                          gla_unit<1>(lds, Z + (size_t)(64 * n) * ZP, 64, wgu, bgp, h, nullptr, nullptr, DS + (size_t)v * 8192, nullptr, glang, OB + (size_t)(64 * n) * OP + 128 * h);
#endif
                      } else { const int v = (int)u - 1664, b = v >> 2, h = v & 3; const int R0 = MP + 16 * b;
#ifndef SKIP_GLA12
                          gla_unit<2>(lds, Z + (size_t)R0 * ZP, 16, wgu, bgp, h, nullptr, nullptr, P.state_gla + ((size_t)(l * 32 + b) * 4 + h) * 8192, P.out + O_SS + ((size_t)(l * 32 + b) * 4 + h) * 8192, glang, OB + (size_t)R0 * OP + 128 * h);
#endif
 }
                  } }
                GSYNC();
                run_gemm(lds, OA, WOA + (size_t)l * DM * 512, MP, DM, 512, pg8::EpiGate<false>{MIX, nullptr, DM, Z + GA_OFF, ZP});
                run_gemm(lds, OB, WOB + (size_t)l * DM * 512, MP, DM, 512, pg8::EpiGate<true>{MIX, MIX, DM, Z + GB_OFF, ZP});
                gemm_small<1>(lds, OA + (size_t)MP * OP, WOA + (size_t)l * DM * 512, 512, OB + (size_t)MP * OP, WOB + (size_t)l * DM * 512, 512, MIX + (size_t)MP * DM, DM, Z + (size_t)MP * ZP);
                GSYNC();
                run_gemm(lds, MIX, WO + (size_t)l * DM * DM, MP, DM, DM, pg8::EpiPlain{Y, DM});
                gemm_small<0>(lds, MIX + (size_t)MP * DM, WO + (size_t)l * DM * DM, DM, nullptr, nullptr, 0, Y + (size_t)MP * DM, DM, nullptr);
                GSYNC();
                rownorm_phase(xbuf, xbuf + (size_t)MP * DM, xbuf, Y, ng + 3 * DM, 1.0f, ng + 4 * DM, H, gw, NGW, lane);
                GSYNC();
#if defined(STOP_AT) && STOP_AT == 4
                return;
#endif

        }
        run_gemm(lds, H, WGU + (size_t)(l * 2 + 1) * NGU * DM, MALL, NGU, DM, pg8::EpiSwiGLU{ACT, DFF});
        GSYNC();
        run_gemm(lds, ACT, WD + (size_t)(l * 2 + 1) * DM * DFF, MP, DM, DFF, pg8::EpiPlain{Y, DM});
        gemm_small<0>(lds, ACT + (size_t)MP * DFF, WD + (size_t)(l * 2 + 1) * DM * DFF, DFF, nullptr, nullptr, 0, Y + (size_t)MP * DM, DM, nullptr);
        GSYNC();
        if (l == 0) { rownorm_phase(xbuf, xbuf + (size_t)MP * DM, xbuf, Y, ng + 5 * DM, 0.5f, P.norm_g + 6 * DM, H, gw, NGW, lane); GSYNC(); }
        else rownorm_phase(xbuf, xbuf + (size_t)MP * DM, xbuf, Y, ng + 5 * DM, 0.5f, nullptr, nullptr, gw, NGW, lane);
    }
}

#undef WSB
#undef NEWPHASE
#undef GSYNC
#undef PB
#undef PF
#undef ctr
#undef WGU
#undef WD
#undef WIN
#undef WOA
#undef WOB
#undef WO
#undef H
#undef ACT
#undef Y
#undef Z
#undef OA
#undef OB
#undef MIX
#undef KC
#undef VC
#undef DS
#undef DEC
#undef ropec
#undef ropes
#undef xbuf
extern "C" void kernel_launch(void* const* d_in, const int* in_sizes, int n_in, void* d_out, int out_size, void* d_ws, size_t ws_size, hipStream_t stream) {
    static int grid_blocks = 0;
    if (grid_blocks == 0) {
        if (n_in != 18 || (size_t)out_size != O_END || ws_size < W_END) { fprintf(stderr, "kernel_launch: unexpected sizes n_in %d out %d ws %zu (need %zu)\n", n_in, out_size, ws_size, (size_t)W_END); grid_blocks = -1; return; }
        int dev = 0, cus = 0, per_cu = 0;
        hipGetDevice(&dev); hipDeviceGetAttribute(&cus, hipDeviceAttributeMultiprocessorCount, dev);
        if (hipFuncSetAttribute((const void*)mega_fwd, hipFuncAttributeMaxDynamicSharedMemorySize, LDS_TOTAL) != hipSuccess) { fprintf(stderr, "kernel_launch: hipFuncSetAttribute failed\n"); grid_blocks = -1; return; }
        if (hipOccupancyMaxActiveBlocksPerMultiprocessor(&per_cu, (const void*)mega_fwd, 512, LDS_TOTAL) != hipSuccess || per_cu < 1) { fprintf(stderr, "kernel_launch: occupancy query gave %d\n", per_cu); per_cu = 1; }
        (void)hipGetLastError();
        grid_blocks = cus * 1;
    }
    if (grid_blocks < 0) return;
    Params p{};
    const float** pp = (const float**)&p;
    for (int i = 0; i < 18; ++i) pp[i] = (const float*)d_in[i];
    p.out = (float*)d_out; p.ws = (unsigned char*)d_ws;
    for (int d = 0; d < 32; ++d) p.inv_freq[d] = (float)exp(-log(10000.0) * (double)d / 32.0);
    if (hipMemsetAsync((char*)d_ws + W_CTR, 0, 65536, stream) != hipSuccess) { fprintf(stderr, "kernel_launch: memset failed\n"); return; }
    void* args[] = {&p};
    hipError_t e = hipLaunchCooperativeKernel((const void*)mega_fwd, dim3(grid_blocks), dim3(512), args, LDS_TOTAL, stream);
    if (e != hipSuccess) fprintf(stderr, "cooperative launch failed: %s (grid %d)\n", hipGetErrorString(e), grid_blocks);
}
```

```cpp
#include <hip/hip_runtime.h>
#include <hip/hip_cooperative_groups.h>
#include <cstdio>
#include <cstdint>
#include <cmath>
namespace cg = cooperative_groups;
#define GAS __attribute__((address_space(1)))
namespace pg8 {
#define PG8_LAS __attribute__((address_space(3)))
typedef unsigned short bf16_t;
typedef short bf16x8 __attribute__((ext_vector_type(8)));
typedef float f32x4 __attribute__((ext_vector_type(4)));
typedef unsigned u32x4 __attribute__((ext_vector_type(4)));
constexpr int BM = 256, BK = 64, HALF = 128, HTB = HALF * BK * 2  , STAGE_BYTES = 8 * HTB, NXCD = 8, WGM = 5;

__host__ __device__ __forceinline__ int lds_byte(int r, int c) { const int st = (r >> 4) * 2 + (c >> 5), rr = r & 15, cc = c & 31, ob = rr * 64 + cc * 2; return st * 1024 + (ob ^ (((ob >> 9) & 1) << 5)); }
__host__ __device__ __forceinline__ void stage_rc(int b, int& R, int& C) { const int st = b / 1024, sb = b % 1024, swz = sb ^ (((sb >> 9) & 1) << 5); R = (st >> 1) * 16 + swz / 64; C = (st & 1) * 32 + (swz % 64) / 2; }
__host__ __device__ __forceinline__ int perm32(int rho) { const int n = rho >> 4, i = rho & 15; return 8 * (i >> 2) + 4 * n + (i & 3); }

struct Unit { int pm, pn; };
struct Gemm { const bf16_t* A; const bf16_t* Bt; int M, N, K; };

struct StaticOrder {
    int nM, nN, nwg, G, c;
    __host__ __device__ void init(int M, int N, int G_, int c_) { nM = M / BM; nN = N / BM; nwg = nM * nN; G = G_; c = c_; }
    __host__ __device__ bool next(int i, Unit& u) const {
        const long L = (long)i * G + c; if (L >= nwg) return false;
        int wgid = (int)L; { const int q = nwg / NXCD, r = nwg % NXCD, xcd = wgid % NXCD, off = wgid / NXCD; wgid = (xcd < r ? xcd * (q + 1) : r * (q + 1) + (xcd - r) * q) + off; }
        const int nig = WGM * nN, gid = wgid / nig, fm = gid * WGM, gsz = (nM - fm) < WGM ? (nM - fm) : WGM;
        u.pm = fm + ((wgid % nig) % gsz); u.pn = (wgid % nig) / gsz; return true;
    }
    __device__ __forceinline__ void a_ready(const Unit&) const {}
    __device__ __forceinline__ void done(const Unit&) const {}
};

__device__ __forceinline__ unsigned cvt_pk_bf16(float lo, float hi) { unsigned r; asm volatile("v_cvt_pk_bf16_f32 %0, %1, %2" : "=v"(r) : "v"(lo), "v"(hi)); return r; }
typedef float f32x2 __attribute__((ext_vector_type(2)));
__device__ __forceinline__ float fast_sigmoid(float x) { return __builtin_amdgcn_rcpf(1.0f + __builtin_amdgcn_exp2f(-1.4426950408889634f * x)); }
__device__ __forceinline__ float bf2f(bf16_t b) { return __uint_as_float(((unsigned)b) << 16); }
__device__ __forceinline__ u32x4 pack8(const f32x4& v0, const f32x4& v1) { u32x4 w; w.x = cvt_pk_bf16(v0[0], v0[1]); w.y = cvt_pk_bf16(v0[2], v0[3]); w.z = cvt_pk_bf16(v1[0], v1[1]); w.w = cvt_pk_bf16(v1[2], v1[3]); return w; }
__device__ __forceinline__ void unpack8(const u32x4& w, f32x4& v0, f32x4& v1) {
    v0[0] = __uint_as_float(w.x << 16); v0[1] = __uint_as_float(w.x & 0xffff0000u); v0[2] = __uint_as_float(w.y << 16); v0[3] = __uint_as_float(w.y & 0xffff0000u);
    v1[0] = __uint_as_float(w.z << 16); v1[1] = __uint_as_float(w.z & 0xffff0000u); v1[2] = __uint_as_float(w.w << 16); v1[3] = __uint_as_float(w.w & 0xffff0000u); }

struct EpiPlain {
    static constexpr bool PERM = true, AFTER_DRAIN = false;
    bf16_t* O; int ldc;
    __device__ __forceinline__ void operator()(const f32x4 (&acc)[2][2][4][2], const Unit& u, int wr, int wc, int fr, int fq) const {
        const int row0 = u.pm * BM + wr * 64 + fr, col0 = u.pn * BM + wc * 32 + 8 * fq;
#pragma unroll
        for (int ai = 0; ai < 2; ++ai)
#pragma unroll
            for (int m = 0; m < 4; ++m) { bf16_t* rowp = O + (size_t)(row0 + ai * HALF + m * 16) * ldc + col0;
#pragma unroll
                for (int bj = 0; bj < 2; ++bj) *(GAS u32x4*)(rowp + bj * HALF) = pack8(acc[ai][bj][m][0], acc[ai][bj][m][1]); }
    }
};
struct EpiSwiGLU {
    static constexpr bool PERM = true, AFTER_DRAIN = false;
    bf16_t* O; int ldc;
    __device__ __forceinline__ void operator()(const f32x4 (&acc)[2][2][4][2], const Unit& u, int wr, int wc, int fr, int fq) const {
        const int row0 = u.pm * BM + wr * 64 + fr, col0 = u.pn * HALF + wc * 32 + 8 * fq;
#pragma unroll
        for (int ai = 0; ai < 2; ++ai)
#pragma unroll
            for (int m = 0; m < 4; ++m) { bf16_t* rowp = O + (size_t)(row0 + ai * HALF + m * 16) * ldc + col0;
                f32x4 r0, r1;
#pragma unroll
                for (int i = 0; i < 4; ++i) { const float g0 = acc[ai][0][m][0][i], g1 = acc[ai][0][m][1][i];
                    r0[i] = g0 * fast_sigmoid(g0) * acc[ai][1][m][0][i]; r1[i] = g1 * fast_sigmoid(g1) * acc[ai][1][m][1][i]; }
                *(GAS u32x4*)rowp = pack8(r0, r1); }
    }
};
template <bool ADD> struct EpiGate {
    static constexpr bool PERM = true, AFTER_DRAIN = false;
    bf16_t* O; const bf16_t* P; int ldc; const bf16_t* G; int ldg;
    __device__ __forceinline__ void operator()(const f32x4 (&acc)[2][2][4][2], const Unit& u, int wr, int wc, int fr, int fq) const {
        const int row0 = u.pm * BM + wr * 64 + fr, col0 = u.pn * BM + wc * 32 + 8 * fq;
        u32x4 gq[2][2], pq[2][2];
#define EG_LOAD(IT, SL) do { const size_t row_ = (size_t)(row0 + ((IT) >> 2) * HALF + ((IT) & 3) * 16); \
            _Pragma("unroll") for (int bj = 0; bj < 2; ++bj) { gq[SL][bj] = *(const GAS u32x4*)(G + row_ * ldg + col0 + bj * HALF); if (ADD) pq[SL][bj] = *(const GAS u32x4*)(P + row_ * ldc + col0 + bj * HALF); } } while (0)
        EG_LOAD(0, 0);
#pragma unroll
        for (int it = 0; it < 8; ++it) { const int ai = it >> 2, m = it & 3; const size_t row = (size_t)(row0 + ai * HALF + m * 16);
            if (it + 1 < 8) { if ((it & 1) == 0) EG_LOAD(it + 1, 1); else EG_LOAD(it + 1, 0); }
#pragma unroll
            for (int bj = 0; bj < 2; ++bj) { const int col = col0 + bj * HALF;
                f32x4 g0, g1; unpack8(gq[it & 1][bj], g0, g1);
                f32x4 p0 = {0.f, 0.f, 0.f, 0.f}, p1 = {0.f, 0.f, 0.f, 0.f};
                if (ADD) unpack8(pq[it & 1][bj], p0, p1);
                f32x4 r0, r1;
#pragma unroll
                for (int i = 0; i < 4; ++i) { r0[i] = p0[i] + fast_sigmoid(g0[i]) * acc[ai][bj][m][0][i]; r1[i] = p1[i] + fast_sigmoid(g1[i]) * acc[ai][bj][m][1][i]; }
                *(GAS u32x4*)(O + row * ldc + col) = pack8(r0, r1); }
            asm volatile("" ::: "memory"); }
#undef EG_LOAD
    }
};
typedef unsigned u32x2 __attribute__((ext_vector_type(2)));
struct EpiInProj {
    static constexpr bool PERM = true, AFTER_DRAIN = false;
    bf16_t* Z; int ldz; const float* ropec; const float* ropes;
    float* kout_p; float* vout_p; float* kout_s; float* vout_s; bf16_t* KC; bf16_t* VC; float qscale;
    __device__ __forceinline__ void operator()(const f32x4 (&acc)[2][2][4][2], const Unit& u, int wr, int wc, int fr, int fq) const {
        const int pn = u.pn; const int row0 = u.pm * BM + wr * 64 + fr;
        if (pn < 4) {
            const bool isk = pn >= 2; const int sec = isk ? 512 : 0, pnl = pn & 1, dbase = 16 * (wc & 1) + 4 * fq;
            f32x4 csq[2], snq[2];
#define EI_LOAD(IT, SL) do { const int row_ = row0 + ((IT) >> 2) * HALF + ((IT) & 3) * 16; const int pos_ = (row_ >= 16384) ? 2048 + ((row_ - 16384) & 15) : row_; \
                csq[SL] = *(const GAS f32x4*)(ropec + pos_ * 32 + dbase); snq[SL] = *(const GAS f32x4*)(ropes + pos_ * 32 + dbase); } while (0)
            EI_LOAD(0, 0);
#pragma unroll
            for (int it = 0; it < 8; ++it) { const int ai = it >> 2, m = it & 3; const int row = row0 + ai * HALF + m * 16; const bool smp = row >= 16384; const int sr = row - 16384;
                    if (it + 1 < 8) { if ((it & 1) == 0) EI_LOAD(it + 1, 1); else EI_LOAD(it + 1, 0); }
                    const f32x4 cs = csq[it & 1], sn = snq[it & 1];
#pragma unroll
                    for (int bj = 0; bj < 2; ++bj) { const int head = 4 * pnl + 2 * bj + (wc >> 1);
                        const f32x4 a0 = acc[ai][bj][m][0], a1 = acc[ai][bj][m][1];
                        const f32x4 x1 = {a0[0], a0[2], a1[0], a1[2]}, x2 = {a0[1], a0[3], a1[1], a1[3]};
                        f32x4 y1 = x1 * cs - x2 * sn, y2 = x2 * cs + x1 * sn;
                        const int hc = head * 64 + dbase;
                        if (isk) {
                            float* ko = smp ? kout_s + (size_t)sr * 512 + hc : kout_p + (size_t)row * 512 + hc;
                            *(GAS f32x4*)ko = y1; *(GAS f32x4*)(ko + 32) = y2;
                        } else { y1 = y1 * qscale; y2 = y2 * qscale; }
                        u32x2 w1, w2; w1.x = cvt_pk_bf16(y1[0], y1[1]); w1.y = cvt_pk_bf16(y1[2], y1[3]); w2.x = cvt_pk_bf16(y2[0], y2[1]); w2.y = cvt_pk_bf16(y2[2], y2[3]);
                        bf16_t* zp = Z + (size_t)row * ldz + sec + hc; *(GAS u32x2*)zp = w1; *(GAS u32x2*)(zp + 32) = w2;
                        if (isk && smp) { bf16_t* kc = KC + ((size_t)(sr >> 4) * 2112 + 2048 + (sr & 15)) * 512 + hc; *(GAS u32x2*)kc = w1; *(GAS u32x2*)(kc + 32) = w2; } }
                    asm volatile("" ::: "memory"); }
#undef EI_LOAD
        } else {
            const int col0 = pn * BM + wc * 32 + 8 * fq; const float sc = (pn == 6) ? 0.125f : 1.0f; const bool isv = (pn == 4 || pn == 5);
#pragma unroll
            for (int ai = 0; ai < 2; ++ai)
#pragma unroll
                for (int m = 0; m < 4; ++m) { const int row = row0 + ai * HALF + m * 16; const bool smp = row >= 16384; const int sr = row - 16384;
#pragma unroll
                    for (int bj = 0; bj < 2; ++bj) { const int col = col0 + bj * HALF;
                        const f32x4 v0 = acc[ai][bj][m][0] * sc, v1 = acc[ai][bj][m][1] * sc; const u32x4 w = pack8(v0, v1);
                        *(GAS u32x4*)(Z + (size_t)row * ldz + col) = w;
                        if (isv) { const int vc = col - 1024; float* vo = smp ? vout_s + (size_t)sr * 512 + vc : vout_p + (size_t)row * 512 + vc;
                            *(GAS f32x4*)vo = v0; *(GAS f32x4*)(vo + 4) = v1;
                            if (smp) *(GAS u32x4*)(VC + ((size_t)(sr >> 4) * 2112 + 2048 + (sr & 15)) * 512 + vc) = w; } }
                    asm volatile("" ::: "memory"); }
        }
    }
};

struct PanelRms {
    unsigned* xs;
    unsigned* cnt;
    float eps;
    __device__ __forceinline__ void run(const f32x4 (&v)[2][2][4][2], const Unit& u, int wr, int wc, int fr, int fq, PG8_LAS unsigned char* lds, int wid, int lane) const {
        PG8_LAS float* P = (PG8_LAS float*)lds;
        PG8_LAS float* S = (PG8_LAS float*)(lds + 4096);
#pragma unroll
        for (int ai = 0; ai < 2; ++ai)
#pragma unroll
            for (int m = 0; m < 4; ++m) { float s = 0.f;
#pragma unroll
                for (int bj = 0; bj < 2; ++bj)
#pragma unroll
                    for (int n = 0; n < 2; ++n) { const f32x4 x = v[ai][bj][m][n]; s += (x[0] * x[0] + x[1] * x[1]) + (x[2] * x[2] + x[3] * x[3]); }
                s += __shfl_xor(s, 16); s += __shfl_xor(s, 32);
                if (fq == 0) P[(ai * HALF + wr * 64 + m * 16 + fr) * 4 + wc] = s; }
        asm volatile("s_waitcnt lgkmcnt(0)" ::: "memory"); __builtin_amdgcn_s_barrier(); asm volatile("" ::: "memory");
        const int row = wid * 32 + (lane & 31);
        if (lane < 32) { const float tot = (P[row * 4 + 0] + P[row * 4 + 1]) + (P[row * 4 + 2] + P[row * 4 + 3]);
            __hip_atomic_store(xs + (size_t)(u.pm * BM + row) * 4 + u.pn, __float_as_uint(tot), __ATOMIC_RELAXED, __HIP_MEMORY_SCOPE_AGENT); }
        asm volatile("s_waitcnt vmcnt(0)" ::: "memory");
        if (lane == 0) __hip_atomic_fetch_add(cnt + 64 * u.pm, 1u, __ATOMIC_RELAXED, __HIP_MEMORY_SCOPE_AGENT);
        if (wid == 0) { unsigned sp = 0u;
            while ((unsigned)__builtin_amdgcn_readfirstlane(__hip_atomic_load(cnt + 64 * u.pm, __ATOMIC_RELAXED, __HIP_MEMORY_SCOPE_AGENT)) < 32u) { __builtin_amdgcn_s_sleep(2); if (++sp > (1u << 22)) break; }
            __builtin_amdgcn_fence(__ATOMIC_ACQUIRE, "agent"); }
        asm volatile("s_waitcnt vmcnt(0) lgkmcnt(0)" ::: "memory"); __builtin_amdgcn_s_barrier(); asm volatile("" ::: "memory");
        if (lane < 32) { const unsigned* sl = xs + (size_t)(u.pm * BM + row) * 4; float t = 0.f;
#pragma unroll
            for (int k = 0; k < 4; ++k) t += __uint_as_float(__hip_atomic_load(sl + k, __ATOMIC_RELAXED, __HIP_MEMORY_SCOPE_AGENT));
            S[row] = __builtin_amdgcn_rsqf(t * (1.0f / 1024.0f) + eps); }
        asm volatile("s_waitcnt lgkmcnt(0)" ::: "memory"); __builtin_amdgcn_s_barrier(); asm volatile("" ::: "memory");
    }
};
struct EpiRmsRes {
    static constexpr bool PERM = false, AFTER_DRAIN = true;
    float* x; bf16_t* H; int ldc; const float* ga; float cy; const float* gb; PanelRms st1, st2;
    __device__ __forceinline__ void fused(f32x4 (&acc)[2][2][4][2], const Unit& u, int wr, int wc, int fr, int fq, PG8_LAS unsigned char* lds, int wid, int lane) const {
        const PG8_LAS float* S = (const PG8_LAS float*)(lds + 4096);
        const int col0 = u.pn * BM + wc * 32 + 4 * fq;
        st1.run(acc, u, wr, wc, fr, fq, lds, wid, lane);
        { f32x4 g1[2][2];
#pragma unroll
          for (int bj = 0; bj < 2; ++bj)
#pragma unroll
              for (int n = 0; n < 2; ++n) g1[bj][n] = *(const GAS f32x4*)(ga + col0 + bj * HALF + n * 16) * cy;
#pragma unroll
          for (int ai = 0; ai < 2; ++ai)
#pragma unroll
              for (int m = 0; m < 4; ++m) { const int r = ai * HALF + wr * 64 + m * 16 + fr; const float sr = S[r]; const size_t off = (size_t)(u.pm * BM + r) * ldc + col0;
#pragma unroll
                  for (int bj = 0; bj < 2; ++bj)
#pragma unroll
                      for (int n = 0; n < 2; ++n) { const f32x4 bs = *(const GAS f32x4*)(x + off + bj * HALF + n * 16); acc[ai][bj][m][n] = bs + acc[ai][bj][m][n] * g1[bj][n] * sr; }
                  asm volatile("" : "+v"(acc[ai][0][m][0]), "+v"(acc[ai][0][m][1]), "+v"(acc[ai][1][m][0]), "+v"(acc[ai][1][m][1]));
                  if (m & 1) asm volatile("" ::: "memory"); } }
        const bool two = (gb != nullptr);
        if (two) st2.run(acc, u, wr, wc, fr, fq, lds, wid, lane);
        f32x4 g2[2][2];
#pragma unroll
        for (int bj = 0; bj < 2; ++bj)
#pragma unroll
            for (int n = 0; n < 2; ++n) g2[bj][n] = two ? *(const GAS f32x4*)(gb + col0 + bj * HALF + n * 16) : (f32x4){0.f, 0.f, 0.f, 0.f};
#pragma unroll
        for (int ai = 0; ai < 2; ++ai)
#pragma unroll
            for (int m = 0; m < 4; ++m) { const int r = ai * HALF + wr * 64 + m * 16 + fr; const float sr = S[r]; const size_t off = (size_t)(u.pm * BM + r) * ldc + col0;
#pragma unroll
                for (int bj = 0; bj < 2; ++bj)
#pragma unroll
                    for (int n = 0; n < 2; ++n) { const f32x4 x1 = acc[ai][bj][m][n]; *(GAS f32x4*)(x + off + bj * HALF + n * 16) = x1;
                        if (two) { const f32x4 o = x1 * g2[bj][n] * sr; u32x2 w; w.x = cvt_pk_bf16(o[0], o[1]); w.y = cvt_pk_bf16(o[2], o[3]); *(GAS u32x2*)(H + off + bj * HALF + n * 16) = w; } }
                asm volatile("" ::: "memory"); }
    }
};
template <class Epi, class Sched, bool ALIGN_EPI = false, bool SP2 = false>
__device__ __forceinline__ void gemm_phase(PG8_LAS unsigned char* lds, const Gemm g, const Sched& S, const Epi& E) {
    int tid_ = threadIdx.x; asm volatile("" : "+v"(tid_));
    const int tid = tid_, wid = __builtin_amdgcn_readfirstlane(tid >> 6), lane = tid & 63, wr = wid >> 2, wc = wid & 3, fr = lane & 15, fq = lane >> 4;
    const int K = g.K, nt = K / BK;
    unsigned voffA[2], voffB[2];
#pragma unroll
    for (int i = 0; i < 2; ++i) { int R, C; stage_rc(tid * 16 + i * 8192, R, C); const int Rb = Epi::PERM ? ((R & ~31) + perm32(R & 31)) : R;
        voffA[i] = (unsigned)(R * K + C) * 2u; voffB[i] = (unsigned)(Rb * K + C) * 2u; }
    const size_t kstep = (size_t)(BK * 2);
    const size_t hstep = (size_t)HALF * K * 2;
    const size_t tstep = 2 * hstep;
    const unsigned ldsw = (unsigned)wid * 1024u;
    const int aoff = lds_byte(wr * 64 + fr, fq * 8), boff = lds_byte(wc * 32 + fr, fq * 8);
#define PG8_SA(b, h) (((b) * 2 + (h)) * HTB)
#define PG8_SB(b, h) ((4 + (b) * 2 + (h)) * HTB)
#define PG8_STAGE(bufoff, gbase, voff) do { _Pragma("unroll") for (int _i = 0; _i < 2; ++_i) \
        __builtin_amdgcn_global_load_lds((const unsigned*)((const char*)(gbase) + (voff)[_i]), (PG8_LAS unsigned*)(lds + (bufoff) + ldsw + _i * 8192), 16, 0, 0); } while (0)
#define PG8_LDA(dst, b, h) do { _Pragma("unroll") for (int m = 0; m < 4; ++m) _Pragma("unroll") for (int k = 0; k < 2; ++k) dst[m][k] = *(const PG8_LAS bf16x8*)(lds + PG8_SA(b, h) + aoff + m * 2048 + k * 1024); } while (0)
#define PG8_LDB(dst, b, h) do { _Pragma("unroll") for (int n = 0; n < 2; ++n) _Pragma("unroll") for (int k = 0; k < 2; ++k) dst[n][k] = *(const PG8_LAS bf16x8*)(lds + PG8_SB(b, h) + boff + n * 2048 + k * 1024); } while (0)
#define PG8_MMA(ai, bj, At, Bt) do { __builtin_amdgcn_s_setprio(1); _Pragma("unroll") for (int m = 0; m < 4; ++m) _Pragma("unroll") for (int n = 0; n < 2; ++n) _Pragma("unroll") for (int k = 0; k < 2; ++k) \
        acc[ai][bj][m][n] = __builtin_amdgcn_mfma_f32_16x16x32_bf16(Bt[n][k], At[m][k], acc[ai][bj][m][n], 0, 0, 0); __builtin_amdgcn_s_setprio(0); } while (0)
#define PG8_WAIT_V(n) asm volatile("s_waitcnt vmcnt(" #n ")" ::: "memory")
#define PG8_WAIT_L(n) asm volatile("s_waitcnt lgkmcnt(" #n ")" ::: "memory")
#define PG8_BAR __builtin_amdgcn_s_barrier()
#define PG8_SCHED __builtin_amdgcn_sched_barrier(0)
    Unit cur, nxt; int ui = 0;
    if (!S.next(0, cur)) return;
    f32x4 acc[2][2][4][2];
#pragma unroll
    for (int a = 0; a < 2; ++a)
#pragma unroll
        for (int b = 0; b < 2; ++b)
#pragma unroll
            for (int m = 0; m < 4; ++m)
#pragma unroll
                for (int n = 0; n < 2; ++n) acc[a][b][m][n] = (f32x4){0.f, 0.f, 0.f, 0.f};
    bf16x8 At[4][2], B0[2][2], B1[2][2];
    const char* cA = (const char*)g.A + (size_t)cur.pm * tstep; const char* cB = (const char*)g.Bt + (size_t)cur.pn * tstep;
    S.a_ready(cur);
    if constexpr (SP2) {
        PG8_STAGE(PG8_SB(0, 0), cB, voffB); PG8_STAGE(PG8_SB(0, 1), cB + hstep, voffB); PG8_STAGE(PG8_SA(0, 0), cA, voffA); PG8_STAGE(PG8_SA(0, 1), cA + hstep, voffA);
        if (wr == 1) PG8_BAR;
        PG8_WAIT_V(2); PG8_BAR;
        PG8_STAGE(PG8_SB(1, 0), cB + kstep, voffB); PG8_STAGE(PG8_SA(1, 0), cA + kstep, voffA); PG8_STAGE(PG8_SB(1, 1), cB + hstep + kstep, voffB);
        PG8_WAIT_V(6); PG8_BAR;
    } else {
        PG8_STAGE(PG8_SB(0, 0), cB, voffB); PG8_STAGE(PG8_SA(0, 0), cA, voffA); PG8_STAGE(PG8_SB(0, 1), cB + hstep, voffB); PG8_STAGE(PG8_SA(0, 1), cA + hstep, voffA);
        if (wr == 1) PG8_BAR;
        PG8_WAIT_V(4); PG8_BAR;
        PG8_STAGE(PG8_SB(1, 0), cB + kstep, voffB); PG8_STAGE(PG8_SA(1, 0), cA + kstep, voffA); PG8_STAGE(PG8_SB(1, 1), cB + hstep + kstep, voffB);
        PG8_WAIT_V(6); PG8_BAR;
    }
    for (;;) {
        const bool has_next = S.next(ui + 1, nxt);
        const char* nA = has_next ? (const char*)g.A + (size_t)nxt.pm * tstep : cA; const char* nB = has_next ? (const char*)g.Bt + (size_t)nxt.pn * tstep : cB;
        for (int t = 0; t < nt; t += 2) {
            const bool last = (t == nt - 2);
            const char* a1 = cA + (size_t)(t + 1) * kstep;
            const char* a2 = last ? nA : cA + (size_t)(t + 2) * kstep; const char* b2 = last ? nB : cB + (size_t)(t + 2) * kstep;
            const char* a3 = a2 + kstep; const char* b3 = b2 + kstep;
            if (last && has_next) S.a_ready(nxt);
            if constexpr (SP2) {
            PG8_LDB(B0, 0, 0); PG8_LDB(B1, 0, 1); PG8_SCHED; PG8_LDA(At, 0, 0); PG8_STAGE(PG8_SA(1, 1), a1 + hstep, voffA);
            PG8_WAIT_V(8); PG8_WAIT_L(0); PG8_BAR; PG8_MMA(0, 0, At, B0); PG8_MMA(0, 1, At, B1); PG8_BAR; PG8_SCHED;
            PG8_LDA(At, 0, 1); PG8_STAGE(PG8_SB(0, 0), b2, voffB); PG8_STAGE(PG8_SB(0, 1), b2 + hstep, voffB); PG8_STAGE(PG8_SA(0, 0), a2, voffA);
            PG8_WAIT_V(8); PG8_WAIT_L(0); PG8_BAR; PG8_MMA(1, 0, At, B0); PG8_MMA(1, 1, At, B1); PG8_BAR; PG8_SCHED;
            PG8_LDB(B0, 1, 0); PG8_LDB(B1, 1, 1); PG8_SCHED; PG8_LDA(At, 1, 0); PG8_STAGE(PG8_SA(0, 1), a2 + hstep, voffA);
            PG8_WAIT_V(8); PG8_WAIT_L(0); PG8_BAR; PG8_MMA(0, 0, At, B0); PG8_MMA(0, 1, At, B1); PG8_BAR; PG8_SCHED;
            PG8_LDA(At, 1, 1); PG8_STAGE(PG8_SB(1, 0), b3, voffB); PG8_STAGE(PG8_SB(1, 1), b3 + hstep, voffB); PG8_STAGE(PG8_SA(1, 0), a3, voffA);
            PG8_WAIT_V(8); PG8_WAIT_L(0); PG8_BAR; PG8_MMA(1, 0, At, B0); PG8_MMA(1, 1, At, B1); PG8_BAR; PG8_SCHED;
            } else {
            PG8_LDB(B0, 0, 0); PG8_SCHED; PG8_LDA(At, 0, 0); PG8_STAGE(PG8_SA(1, 1), a1 + hstep, voffA);
            PG8_WAIT_L(8); PG8_BAR; PG8_WAIT_L(0); PG8_MMA(0, 0, At, B0); PG8_BAR; PG8_SCHED;
            PG8_LDB(B1, 0, 1); PG8_STAGE(PG8_SB(0, 0), b2, voffB);
            PG8_BAR; PG8_WAIT_L(0); PG8_MMA(0, 1, At, B1); PG8_BAR;
            PG8_LDA(At, 0, 1); PG8_STAGE(PG8_SA(0, 0), a2, voffA);
            PG8_BAR; PG8_WAIT_L(0); PG8_MMA(1, 0, At, B0); PG8_BAR; PG8_SCHED;
            PG8_STAGE(PG8_SB(0, 1), b2 + hstep, voffB);
            PG8_WAIT_V(6); PG8_BAR; PG8_MMA(1, 1, At, B1); PG8_BAR;
            PG8_LDB(B0, 1, 0); PG8_SCHED; PG8_LDA(At, 1, 0); PG8_STAGE(PG8_SA(0, 1), a2 + hstep, voffA);
            PG8_WAIT_L(8); PG8_BAR; PG8_WAIT_L(0); PG8_MMA(0, 0, At, B0); PG8_BAR; PG8_SCHED;
            PG8_LDB(B1, 1, 1); PG8_STAGE(PG8_SB(1, 0), b3, voffB);
            PG8_BAR; PG8_WAIT_L(0); PG8_MMA(0, 1, At, B1); PG8_BAR;
            PG8_LDA(At, 1, 1); PG8_STAGE(PG8_SA(1, 0), a3, voffA);
            PG8_BAR; PG8_WAIT_L(0); PG8_MMA(1, 0, At, B0); PG8_BAR; PG8_SCHED;
            PG8_STAGE(PG8_SB(1, 1), b3 + hstep, voffB);
            PG8_WAIT_V(6); PG8_BAR; PG8_MMA(1, 1, At, B1); PG8_BAR;
            }
        }
        if constexpr (ALIGN_EPI) { if (wr == 0) PG8_BAR; }
        if constexpr (!Epi::AFTER_DRAIN) { E(acc, cur, wr, wc, fr, fq); S.done(cur); }
        if (!has_next) break;
#pragma unroll
        for (int a = 0; a < 2; ++a)
#pragma unroll
            for (int b = 0; b < 2; ++b)
#pragma unroll
                for (int m = 0; m < 4; ++m)
#pragma unroll
                    for (int n = 0; n < 2; ++n) acc[a][b][m][n] = (f32x4){0.f, 0.f, 0.f, 0.f};
        cur = nxt; cA = nA; cB = nB; ++ui;
        if constexpr (ALIGN_EPI) { if (wr == 1) PG8_BAR; }
    }
    PG8_WAIT_V(0);
    if constexpr (!ALIGN_EPI) { if (wr == 0) PG8_BAR; }
    PG8_BAR;
    if constexpr (Epi::AFTER_DRAIN) { E.fused(acc, cur, wr, wc, fr, fq, lds, wid, lane); S.done(cur); }
#undef PG8_SA
#undef PG8_SB
#undef PG8_STAGE
#undef PG8_LDA
#undef PG8_LDB
#undef PG8_MMA
#undef PG8_WAIT_V
#undef PG8_WAIT_L
#undef PG8_BAR
#undef PG8_SCHED
}
}
using pg8::bf16_t; using pg8::bf16x8; using pg8::f32x4; using pg8::u32x4; using pg8::u32x2; using pg8::cvt_pk_bf16; using pg8::bf2f;
#define LAS __attribute__((address_space(3)))
typedef float f32x16 __attribute__((ext_vector_type(16)));
typedef short s16x4 __attribute__((ext_vector_type(4)));

constexpr int DM = 1024, MP = 16384, MS = 512, MALL = MP + MS, DFF = 2816, NGU = 2 * DFF, ZP = 5376, PAST = 2048, KCROWS = 2112;
constexpr int QA_OFF = 0, KA_OFF = 512, VA_OFF = 1024, QB_OFF = 1536, KB_OFF = 1792, VB_OFF = 2048, RB_OFF = 2560, GA_OFF = 3072, GB_OFF = 4096, ALR_OFF = 5120;
constexpr int NCHUNK = 256;
constexpr int OP = 512;
constexpr size_t O_Y = 0, O_KP = (size_t)MALL * DM, O_VP = O_KP + 2ull * MP * 512, O_SP = O_VP + 2ull * MP * 512, O_KS = O_SP + 2ull * 4 * 64 * 128,
                 O_VS = O_KS + 2ull * MS * 512, O_SS = O_VS + 2ull * MS * 512, O_END = O_SS + 2ull * 32 * 4 * 64 * 128;
constexpr size_t al256(size_t x) { return (x + 255) & ~(size_t)255; }
constexpr size_t W_CTR = 0;
constexpr size_t W_WGU = 65536;
constexpr size_t W_WD = W_WGU + 4ull * NGU * DM * 2;
constexpr size_t W_WIN = W_WD + 4ull * DM * DFF * 2;
constexpr size_t W_WOA = W_WIN + 2ull * ZP * DM * 2;
constexpr size_t W_WOB = W_WOA + 2ull * DM * 512 * 2;
constexpr size_t W_WO = W_WOB + 2ull * DM * 512 * 2;
constexpr size_t W_H = W_WO + 2ull * DM * DM * 2;
constexpr size_t W_ACT = W_H + (size_t)MALL * DM * 2;
constexpr size_t W_Y = W_ACT + (size_t)MALL * DFF * 2;
constexpr size_t W_Z = W_Y + (size_t)MALL * DM * 2;
constexpr size_t W_OAB = W_Z + (size_t)MALL * ZP * 2;
constexpr size_t W_MIX = W_OAB + (size_t)MALL * DM * 2;
constexpr size_t W_KC = W_MIX + (size_t)MALL * DM * 2;
constexpr size_t W_VC = W_KC + 2ull * 32 * KCROWS * 512 * 2;
constexpr size_t W_DS = W_VC + 2ull * 32 * KCROWS * 512 * 2;
constexpr size_t W_DEC = W_DS + (size_t)NCHUNK * 4 * 64 * 128 * 4;
constexpr size_t W_ROPE = W_DEC + (size_t)NCHUNK * 4 * 64 * 4;
constexpr size_t W_END = W_ROPE + 2ull * MP * 32 * 4;

constexpr int LDS_MAIN = 131072, LDS_TOTAL = LDS_MAIN + 1024;

struct Params {
    const float *x_prompt, *x_sample, *cache_k, *cache_v, *state_gla, *norm_g, *w_gate, *w_up, *w_down, *w_in, *w_gate_up, *b_gate, *lambda_p, *subln_g, *gla_norm_g, *w_out_a, *w_out_b, *w_out;
    float* out; unsigned char* ws;
    float inv_freq[32];
};

__device__ __forceinline__ float wave_sum(float v) {
#pragma unroll
    for (int o = 1; o < 64; o <<= 1) v += __shfl_xor(v, o);
    return v;
}
__device__ __forceinline__ float swap32_add(float v) { auto rr = __builtin_amdgcn_permlane32_swap(__float_as_uint(v), __float_as_uint(v), false, false); return __uint_as_float(rr[0]) + __uint_as_float(rr[1]); }
__device__ __forceinline__ float swap32_max(float v) { auto rr = __builtin_amdgcn_permlane32_swap(__float_as_uint(v), __float_as_uint(v), false, false); return fmaxf(__uint_as_float(rr[0]), __uint_as_float(rr[1])); }
__device__ __forceinline__ float max3f(float a, float b, float c) { float r; asm("v_max3_f32 %0, %1, %2, %3" : "=v"(r) : "v"(a), "v"(b), "v"(c)); return r; }
__device__ __forceinline__ float fadd_s(float a, float b) { float r; asm("v_add_f32_e32 %0, %1, %2" : "=v"(r) : "v"(a), "v"(b)); return r; }
__device__ __forceinline__ int crow(int r, int hi) { return (r & 3) + 8 * (r >> 2) + 4 * hi; }
__device__ __forceinline__ unsigned f2bf(float f) { unsigned u = __float_as_uint(f); return (u + 0x7fffu + ((u >> 16) & 1u)) >> 16; }

__device__ __forceinline__ const float* tr_src(const float* W0, const float* W1, int mode, int np) {
    if (mode == 0) return W0 + np;
    if (mode == 1) { const int r = np & 255, pn = np >> 8; return (r < 128 ? W0 : W1) + 128 * pn + (r & 127); }
    if (np < 1024) { const int j = np & 63; return W0 + (np & ~63) + (j >> 1) + 32 * (j & 1); }
    if (np < 3072) return W0 + np;
    if (np < 5120) return W0 + np + 16;
    if (np < 5136) return W0 + 3072 + (np - 5120);
    return nullptr;
}
__device__ __forceinline__ void transpose_item(const float* W0, const float* W1, int Nsrc, int K, int mode, bf16_t* WT, LAS float* scr, int item, int nblk, int lane) {
    const int kb = item / nblk, nb = item % nblk, k0 = 64 * kb, n0 = 32 * nb;
    if (mode == 2 && n0 < 1024) {
        const float* src = tr_src(W0, W1, mode, n0 + (lane & 31));
#pragma unroll 8
        for (int i = 0; i < 32; ++i) { const int kk = 2 * i + (lane >> 5); scr[kk * 33 + (lane & 31)] = src[(size_t)(k0 + kk) * Nsrc]; }
    } else {
        const int n4 = 4 * (lane & 7); const float* src = tr_src(W0, W1, mode, n0 + n4);
#pragma unroll
        for (int i = 0; i < 8; ++i) { const int kk = 8 * i + (lane >> 3); f32x4 v = {0.f, 0.f, 0.f, 0.f}; if (src) v = *(const GAS f32x4*)(src + (size_t)(k0 + kk) * Nsrc);
            LAS float* d = scr + kk * 33 + n4; d[0] = v[0]; d[1] = v[1]; d[2] = v[2]; d[3] = v[3]; }
    }
    asm volatile("s_waitcnt lgkmcnt(0)" ::: "memory");
    const int c = lane & 7;
#pragma unroll
    for (int j = 0; j < 4; ++j) { const int n = (lane >> 3) + 8 * j; const LAS float* s = scr + (8 * c) * 33 + n;
        u32x4 o; o.x = cvt_pk_bf16(s[0 * 33], s[1 * 33]); o.y = cvt_pk_bf16(s[2 * 33], s[3 * 33]); o.z = cvt_pk_bf16(s[4 * 33], s[5 * 33]); o.w = cvt_pk_bf16(s[6 * 33], s[7 * 33]);
        *(GAS u32x4*)(WT + (size_t)(n0 + n) * K + k0 + 8 * c) = o; }
    asm volatile("s_waitcnt lgkmcnt(0)" ::: "memory");
}

template <int MODE> __device__ __forceinline__ void gemm_small(LAS unsigned char* lds, const bf16_t* A0, const bf16_t* B0, int K0, const bf16_t* A1, const bf16_t* B1, int K1, bf16_t* O, int ldo, const bf16_t* Zs) {
    int tid_ = threadIdx.x; asm volatile("" : "+v"(tid_));
    const int tid = tid_, lane = tid & 63, wid = __builtin_amdgcn_readfirstlane(tid >> 6), r32 = lane & 31, hi = lane >> 5;
    constexpr int NP = MODE == 1 ? 2 : 1;
    LAS float* R = (LAS float*)lds;
    for (int u = blockIdx.x; u < 256; u += gridDim.x) { const int um = u >> 4, un = u & 15;
        f32x16 acc[NP][2];
#pragma unroll
        for (int p = 0; p < NP; ++p)
#pragma unroll
            for (int cb = 0; cb < 2; ++cb)
#pragma unroll
                for (int r = 0; r < 16; ++r) acc[p][cb][r] = 0.f;
#pragma unroll
        for (int p = 0; p < NP; ++p) { const bf16_t* A = p ? A1 : A0; const bf16_t* B = p ? B1 : B0; const int K = p ? K1 : K0;
            const bf16_t* ap = A + (size_t)(32 * um + r32) * K + 8 * hi; const bf16_t* bp0 = B + (size_t)(64 * un + r32) * K + 8 * hi; const bf16_t* bp1 = bp0 + (size_t)32 * K;
            const int nks = K >> 4, per = nks >> 3, kb0 = wid * per;
            for (int ks = 0; ks < per; ks += 4) { bf16x8 a[4], b0[4], b1[4];
#pragma unroll
                for (int j = 0; j < 4; ++j) { const int kk = ks + j; const int kc = kb0 + ((kk < per) ? kk : 0);
                    a[j] = *(const GAS bf16x8*)(ap + 16 * kc); b0[j] = *(const GAS bf16x8*)(bp0 + 16 * kc); b1[j] = *(const GAS bf16x8*)(bp1 + 16 * kc); }
#pragma unroll
                for (int j = 0; j < 4; ++j) if (ks + j < per) {
                    acc[p][0] = __builtin_amdgcn_mfma_f32_32x32x16_bf16(a[j], b0[j], acc[p][0], 0, 0, 0); acc[p][1] = __builtin_amdgcn_mfma_f32_32x32x16_bf16(a[j], b1[j], acc[p][1], 0, 0, 0); } } }
#pragma unroll
        for (int p = 0; p < NP; ++p)
#pragma unroll
            for (int cb = 0; cb < 2; ++cb)
#pragma unroll
                for (int r = 0; r < 16; ++r) R[(((wid * NP + p) * 2 + cb) * 16 + r) * 64 + lane] = acc[p][cb][r];
        __syncthreads();
#pragma unroll
        for (int j = 0; j < 4; ++j) { const int idx = tid + 512 * j, cb = idx >> 10, r = (idx >> 6) & 15, ln = idx & 63; float v[NP];
#pragma unroll
            for (int p = 0; p < NP; ++p) { float s = 0.f;
#pragma unroll
                for (int w = 0; w < 8; ++w) s += R[(((w * NP + p) * 2 + cb) * 16 + r) * 64 + ln];
                v[p] = s; }
            const int row = 32 * um + crow(r, ln >> 5), col = 64 * un + 32 * cb + (ln & 31); float o = v[0];
            if (MODE == 1) { const GAS bf16_t* Zsg = (const GAS bf16_t*)Zs; const float ga = bf2f(Zsg[(size_t)row * ZP + GA_OFF + col]), gb = bf2f(Zsg[(size_t)row * ZP + GB_OFF + col]); o = pg8::fast_sigmoid(ga) * v[0] + pg8::fast_sigmoid(gb) * v[NP - 1]; }
            ((GAS bf16_t*)O)[(size_t)row * ldo + col] = (bf16_t)f2bf(o); }
        __syncthreads();
    }
}

__device__ __forceinline__ void rownorm_phase(const float* xinP, const float* xinS, float* xout, const bf16_t* Y, const float* ga, float cy, const float* gb, bf16_t* H, int gw, int NGW, int lane) {
    for (int m0 = gw; m0 < MALL; m0 += 2 * NGW) {
        int mr[2]; mr[0] = m0; mr[1] = (m0 + NGW < MALL) ? m0 + NGW : m0;
        f32x4 v[2][4]; u32x2 yw[2][4];
#pragma unroll
        for (int u = 0; u < 2; ++u) { const int m = mr[u]; const float* xr = (m < MP) ? xinP + (size_t)m * DM : xinS + (size_t)(m - MP) * DM;
#pragma unroll
            for (int j = 0; j < 4; ++j) v[u][j] = *(const GAS f32x4*)(xr + 4 * lane + 256 * j);
            if (Y) {
#pragma unroll
                for (int j = 0; j < 4; ++j) yw[u][j] = *(const GAS u32x2*)(Y + (size_t)m * DM + 4 * lane + 256 * j); } }
#pragma unroll
        for (int u = 0; u < 2; ++u) { const int m = mr[u];
            if (Y) {
                f32x4 y[4]; float s = 0.f;
#pragma unroll
                for (int j = 0; j < 4; ++j) { const u32x2 w = yw[u][j];
                    y[j][0] = __uint_as_float(w.x << 16); y[j][1] = __uint_as_float(w.x & 0xffff0000u); y[j][2] = __uint_as_float(w.y << 16); y[j][3] = __uint_as_float(w.y & 0xffff0000u);
                    s += (y[j][0] * y[j][0] + y[j][1] * y[j][1]) + (y[j][2] * y[j][2] + y[j][3] * y[j][3]); }
                const float rstd = cy * __builtin_amdgcn_rsqf(wave_sum(s) * (1.f / DM) + 1e-6f);
#pragma unroll
                for (int j = 0; j < 4; ++j) { const f32x4 g = *(const GAS f32x4*)(ga + 4 * lane + 256 * j); v[u][j] = v[u][j] + y[j] * g * rstd; }
            }
#pragma unroll
            for (int j = 0; j < 4; ++j) *(GAS f32x4*)(xout + (size_t)m * DM + 4 * lane + 256 * j) = v[u][j];
            if (H) {
                float s = 0.f;
#pragma unroll
                for (int j = 0; j < 4; ++j) s += (v[u][j][0] * v[u][j][0] + v[u][j][1] * v[u][j][1]) + (v[u][j][2] * v[u][j][2] + v[u][j][3] * v[u][j][3]);
                const float rstd = __builtin_amdgcn_rsqf(wave_sum(s) * (1.f / DM) + 1e-6f);
#pragma unroll
                for (int j = 0; j < 4; ++j) { const f32x4 g = *(const GAS f32x4*)(gb + 4 * lane + 256 * j); const f32x4 o = v[u][j] * g * rstd;
                    u32x2 w; w.x = cvt_pk_bf16(o[0], o[1]); w.y = cvt_pk_bf16(o[2], o[3]); *(GAS u32x2*)(H + (size_t)m * DM + 4 * lane + 256 * j) = w; }
            }
        }
    }
}

__device__ __forceinline__ void attn_unit(LAS unsigned char* lds, const bf16_t* Qp, int q_pitch, int q_clamp, const bf16_t* Kp, const bf16_t* Vp, int kv_pitch, const float* Kf, const float* Vf, int NT, int last_valid,
                                          int sample, int q0, bf16_t* Op, int out_rows, float lam, const float* subg, float oscale) {
    int tid_ = threadIdx.x; asm volatile("" : "+v"(tid_));
    const int tid = tid_, lane = tid & 63, wid = __builtin_amdgcn_readfirstlane(tid >> 6), s = wid & 1, rg = wid >> 1, r32 = lane & 31, hi = lane >> 5;
    const int nt_w = sample ? (rg == 0 ? NT : 0) : (((q0 + 32 * rg) >> 6) + 1);
    bf16x8 qf[4];
    { int qrow = 32 * rg + r32; qrow = qrow < q_clamp ? qrow : q_clamp;
#pragma unroll
      for (int d0 = 0; d0 < 4; ++d0) qf[d0] = *(const GAS bf16x8*)(Qp + (size_t)qrow * q_pitch + 64 * s + 16 * d0 + 8 * hi); }
    const int key0 = tid >> 4, ch = tid & 15;
    const bf16_t* kg = Kp + (size_t)key0 * kv_pitch + ch * 8; const bf16_t* vg = Vp + (size_t)key0 * kv_pitch + ch * 8;
    const size_t g32 = (size_t)32 * kv_pitch, gtile = (size_t)64 * kv_pitch;
    const int kl0 = (ch >> 3) * 8192 + key0 * 128 + (((ch & 7) ^ ((key0 >> 1) & 7)) << 4), kl1 = kl0 + 32 * 128;
    const int vl0 = 16384 + 256 * key0 + 16 * (ch ^ (((key0 & 3) << 2) | ((key0 >> 2) & 3))), vl1 = vl0 + 8192;
    u32x4 ra[4], rb[4];
#define ATT_LOAD(R, T) do { const bf16_t* kgn_ = kg + (size_t)(T) * gtile; const bf16_t* vgn_ = vg + (size_t)(T) * gtile; \
        R[0] = *(const GAS u32x4*)kgn_; R[1] = *(const GAS u32x4*)(kgn_ + g32); R[2] = *(const GAS u32x4*)vgn_; R[3] = *(const GAS u32x4*)(vgn_ + g32); } while (0)
#define ATT_STORE(R, BUF) do { LAS unsigned char* nb_ = lds + (BUF) * 32768; *(LAS u32x4*)(nb_ + kl0) = R[0]; *(LAS u32x4*)(nb_ + kl1) = R[1]; *(LAS u32x4*)(nb_ + vl0) = R[2]; *(LAS u32x4*)(nb_ + vl1) = R[3]; } while (0)
    const int kfo = s * 8192 + r32 * 128;
    const int q4 = (lane & 15) >> 2, g1 = (lane >> 4) & 1, p = lane & 3, c2 = 2 * g1 + (p >> 1);
    const int vbase = 16384 + 256 * (4 * hi + q4) + 8 * (p & 1);
    int cx[2]; const int q464 = 64 * q4;
#pragma unroll
    for (int j = 0; j < 2; ++j) cx[j] = 16 * (c2 ^ (hi + 2 * j)) + 2048 * j;
    f32x16 o[4];
#pragma unroll
    for (int eb = 0; eb < 4; ++eb)
#pragma unroll
        for (int r = 0; r < 16; ++r) o[eb][r] = 0.f;
    float lrun = 0.f;
    f32x16 negm;
#pragma unroll
    for (int r = 0; r < 16; ++r) negm[r] = 0.f;
#define ATT_VRD(KS) do { _Pragma("unroll") for (int eb = 0; eb < 4; ++eb) { \
        vv[2 * eb] = __builtin_bit_cast(s16x4, __builtin_amdgcn_ds_read_tr16_b64_v4i16((LAS s16x4*)(base + vbase + 4096 * (KS) + cx[0] + ((64 * eb) ^ q464)))); \
        vv[2 * eb + 1] = __builtin_bit_cast(s16x4, __builtin_amdgcn_ds_read_tr16_b64_v4i16((LAS s16x4*)(base + vbase + 4096 * (KS) + cx[1] + ((64 * eb) ^ q464)))); } } while (0)
#define ATT_COMPUTE(t) do { \
        if (t < nt_w) { \
            const LAS unsigned char* base = lds + (t & 1) * 32768; \
            f32x16 sA, sB; \
            { const LAS unsigned char* kb_ = base + kfo; bf16x8 kfa_[4], kfb_[4]; \
              _Pragma("unroll") for (int d0 = 0; d0 < 4; ++d0) { const int co = (((2 * d0 + hi) ^ ((r32 >> 1) & 7)) << 4); kfa_[d0] = *(const LAS bf16x8*)(kb_ + co); kfb_[d0] = *(const LAS bf16x8*)(kb_ + 4096 + co); } \
              __builtin_amdgcn_sched_barrier(0); \
              sA = __builtin_amdgcn_mfma_f32_32x32x16_bf16(kfa_[0], qf[0], negm, 0, 0, 0); sB = __builtin_amdgcn_mfma_f32_32x32x16_bf16(kfb_[0], qf[0], negm, 0, 0, 0); \
              _Pragma("unroll") for (int d0 = 1; d0 < 4; ++d0) { sA = __builtin_amdgcn_mfma_f32_32x32x16_bf16(kfa_[d0], qf[d0], sA, 0, 0, 0); sB = __builtin_amdgcn_mfma_f32_32x32x16_bf16(kfb_[d0], qf[d0], sB, 0, 0, 0); } \
              __builtin_amdgcn_sched_barrier(0); } \
            if (t == NT - 1 && last_valid < 64) { \
                _Pragma("unroll") for (int r = 0; r < 16; ++r) { const int kv = crow(r, hi); if (kv >= last_valid) sA[r] = -INFINITY; if (kv + 32 >= last_valid) sB[r] = -INFINITY; } } \
            asm volatile("s_nop 15\n\ts_nop 7" : "+v"(sA), "+v"(sB));     \
            float rm; { float a_ = max3f(sA[0], sA[1], sB[0]), b_ = max3f(sA[2], sA[3], sB[1]); a_ = max3f(a_, sB[2], sB[3]); \
              _Pragma("unroll") for (int r = 4; r < 16; r += 4) { a_ = max3f(a_, sA[r], sA[r + 1]); b_ = max3f(b_, sA[r + 2], sA[r + 3]); a_ = max3f(a_, sB[r], sB[r + 1]); b_ = max3f(b_, sB[r + 2], sB[r + 3]); } \
              rm = fmaxf(a_, b_); } \
            rm = swap32_max(rm); \
            if (t == 0 || __any(rm > 8.0f)) { const float dl = (t == 0) ? rm : fmaxf(rm, 0.f); const float f = __builtin_amdgcn_exp2f(-dl); const float nm = negm[0] - dl; lrun *= f; \
                _Pragma("unroll") for (int eb = 0; eb < 4; ++eb) _Pragma("unroll") for (int r = 0; r < 16; ++r) o[eb][r] *= f; \
                _Pragma("unroll") for (int r = 0; r < 16; ++r) { sA[r] -= dl; sB[r] -= dl; negm[r] = nm; } } \
            _Pragma("unroll") for (int r = 0; r < 16; ++r) { sA[r] = __builtin_amdgcn_exp2f(sA[r]); sB[r] = __builtin_amdgcn_exp2f(sB[r]); } \
            asm volatile("s_nop 1" : "+v"(sA), "+v"(sB));     \
            { float l0_ = sA[0], l1_ = sB[0];     \
              _Pragma("unroll") for (int r = 1; r < 16; ++r) { l0_ = fadd_s(l0_, sA[r]); l1_ = fadd_s(l1_, sB[r]); } \
              lrun += fadd_s(l0_, l1_); } \
            u32x4 pw[4]; \
            _Pragma("unroll") for (int i = 0; i < 4; ++i) { pw[0][i] = cvt_pk_bf16(sA[2 * i], sA[2 * i + 1]); pw[1][i] = cvt_pk_bf16(sA[8 + 2 * i], sA[9 + 2 * i]); pw[2][i] = cvt_pk_bf16(sB[2 * i], sB[2 * i + 1]); pw[3][i] = cvt_pk_bf16(sB[8 + 2 * i], sB[9 + 2 * i]); } \
            s16x4 vv[8]; \
            _Pragma("unroll") for (int ks = 0; ks < 4; ++ks) { const bf16x8 pf = __builtin_bit_cast(bf16x8, pw[ks]); \
                ATT_VRD(ks); \
                __builtin_amdgcn_sched_barrier(0); \
                _Pragma("unroll") for (int eb = 0; eb < 4; ++eb) { const s16x4 lo = vv[2 * eb], hh = vv[2 * eb + 1]; \
                    const bf16x8 vf = {lo[0], lo[1], lo[2], lo[3], hh[0], hh[1], hh[2], hh[3]}; \
                    o[eb] = __builtin_amdgcn_mfma_f32_32x32x16_bf16(vf, pf, o[eb], 0, 0, 0); } \
                __builtin_amdgcn_sched_barrier(0); } \
        } \
        } while (0)
#define ATT_STEP(RW, RN, T) do { const int t_ = (T); \
        if (t_ + 2 < NT) ATT_LOAD(RN, t_ + 2); \
        ATT_COMPUTE(t_); \
        if (t_ + 1 < NT) ATT_STORE(RW, (t_ + 1) & 1); \
        __syncthreads(); } while (0)
    if (!sample) {
        ATT_LOAD(ra, 0);
        if (NT > 1) ATT_LOAD(rb, 1);
        ATT_STORE(ra, 0);
        __syncthreads();
        int tt = 0;
        for (; tt + 1 < NT; tt += 2) { ATT_STEP(rb, ra, tt); ATT_STEP(ra, rb, tt + 1); }
        if (tt < NT) ATT_STEP(rb, ra, tt);
    } else {
        const float* kfp = Kf + (size_t)key0 * 512 + ch * 8; const float* vfp = Vf + (size_t)key0 * 512 + ch * 8;
#define ATT_LOADF(T) do { const float* kfn_ = kfp + (size_t)(T) * 32768; const float* vfn_ = vfp + (size_t)(T) * 32768; \
            ra[0] = *(const GAS u32x4*)kfn_; ra[1] = *(const GAS u32x4*)(kfn_ + 4); ra[2] = *(const GAS u32x4*)(kfn_ + 16384); ra[3] = *(const GAS u32x4*)(kfn_ + 16388); \
            rb[0] = *(const GAS u32x4*)vfn_; rb[1] = *(const GAS u32x4*)(vfn_ + 4); rb[2] = *(const GAS u32x4*)(vfn_ + 16384); rb[3] = *(const GAS u32x4*)(vfn_ + 16388); } while (0)
#define ATT_F4(x) __builtin_bit_cast(f32x4, x)
#define ATT_STOREF(BUF) do { LAS unsigned char* nb_ = lds + (BUF) * 32768; \
            *(LAS u32x4*)(nb_ + kl0) = pg8::pack8(ATT_F4(ra[0]), ATT_F4(ra[1])); *(LAS u32x4*)(nb_ + kl1) = pg8::pack8(ATT_F4(ra[2]), ATT_F4(ra[3])); \
            *(LAS u32x4*)(nb_ + vl0) = pg8::pack8(ATT_F4(rb[0]), ATT_F4(rb[1])); *(LAS u32x4*)(nb_ + vl1) = pg8::pack8(ATT_F4(rb[2]), ATT_F4(rb[3])); } while (0)
        ATT_LOADF(0); ATT_STOREF(0);
        __syncthreads();
        for (int ts = 0; ts < NT; ++ts) {
            if (ts + 2 < NT) ATT_LOADF(ts + 1); else if (ts + 1 < NT) ATT_LOAD(ra, ts + 1);
            ATT_COMPUTE(ts);
            if (ts + 2 < NT) ATT_STOREF((ts + 1) & 1); else if (ts + 1 < NT) ATT_STORE(ra, (ts + 1) & 1);
            __syncthreads();
        }
#undef ATT_LOADF
#undef ATT_F4
#undef ATT_STOREF
    }
#undef ATT_COMPUTE
#undef ATT_LOAD
#undef ATT_STORE
#undef ATT_VRD
#undef ATT_STEP
    const float lt = swap32_add(lrun); const float inv = __builtin_amdgcn_rcpf(lt);
    LAS float* X = (LAS float*)(lds + 65536 + rg * 16384);
    if (s == 1 && nt_w > 0) {
#pragma unroll
        for (int eb = 0; eb < 4; ++eb)
#pragma unroll
            for (int r = 0; r < 16; ++r) X[(eb * 16 + r) * 64 + lane] = o[eb][r] * inv;
    }
    __syncthreads();
    if (s == 0 && nt_w > 0) {
        float ss = 0.f;
#pragma unroll
        for (int eb = 0; eb < 4; ++eb)
#pragma unroll
            for (int r = 0; r < 16; ++r) { const float v = o[eb][r] * inv - lam * X[(eb * 16 + r) * 64 + lane]; o[eb][r] = v; ss += v * v; }
        ss = swap32_add(ss);
        const float rstd = __builtin_amdgcn_rsqf(ss * (1.f / 128.f) + 1e-5f) * oscale;
        const int row = 32 * rg + r32;
        if (row < out_rows) {
#pragma unroll
            for (int eb = 0; eb < 4; ++eb)
#pragma unroll
                for (int g4 = 0; g4 < 4; ++g4) { const int e = 32 * eb + 8 * g4 + 4 * hi; const f32x4 g = *(const GAS f32x4*)(subg + e);
                    u32x2 w; w.x = cvt_pk_bf16(o[eb][4 * g4] * rstd * g[0], o[eb][4 * g4 + 1] * rstd * g[1]); w.y = cvt_pk_bf16(o[eb][4 * g4 + 2] * rstd * g[2], o[eb][4 * g4 + 3] * rstd * g[3]);
                    *(GAS u32x2*)(Op + (size_t)row * OP + e) = w; }
        }
    }
    __syncthreads();
}

constexpr int G_LA = 0, G_ALR = 16640, G_WG = G_ALR + 4096, G_BG = G_WG + 4096, G_SEG = G_BG + 256, G_KE = G_SEG + 2048, G_KDT = G_KE + 9216, G_QE = G_KDT + 9216, G_ATT = G_QE + 9216, G_VT = G_ATT + 9216, G_ST = G_VT + 18432, G_END = G_ST + 18432;
static_assert(G_KDT >= 64 * 132 * 4, "OBUF aliases LA..KE");
static_assert(G_END <= LDS_MAIN, "gla lds");
template <int MODE> __device__ __forceinline__ void gla_unit(LAS unsigned char* lds, const bf16_t* Zr, int ntok, const float* wgu, const float* bgp, int h, float* ds_out, float* dec_out,
                                                              const float* Sprev, float* sfin, const float* glang, bf16_t* Oout) {
    int tid_ = threadIdx.x; asm volatile("" : "+v"(tid_));
    const int tid = tid_, lane = tid & 63, wid = __builtin_amdgcn_readfirstlane(tid >> 6), r32 = lane & 31, hi = lane >> 5;
    const GAS bf16_t* Zg = (const GAS bf16_t*)Zr; const GAS float* wgu_g = (const GAS float*)wgu; const GAS float* bg_g = (const GAS float*)bgp; const GAS float* Sp_g = (const GAS float*)Sprev;
    GAS float* ds_g = (GAS float*)ds_out; GAS float* dec_g = (GAS float*)dec_out; GAS float* sf_g = (GAS float*)sfin; const GAS float* gl_g = (const GAS float*)glang;
    const int pt = tid >> 3, pd8 = (tid & 7) * 8, vt0 = tid >> 4, vc8 = (tid & 15) * 8;
    u32x4 qw = {0u, 0u, 0u, 0u}, kw = qw, vw0 = qw, vw1 = qw, rw0 = qw, rw1 = qw; f32x4 sw[4];
    if (pt < ntok) { qw = *(const GAS u32x4*)(Zg + (size_t)pt * ZP + QB_OFF + 64 * h + pd8); kw = *(const GAS u32x4*)(Zg + (size_t)pt * ZP + KB_OFF + 64 * h + pd8); }
    if (vt0 < ntok) vw0 = *(const GAS u32x4*)(Zg + (size_t)vt0 * ZP + VB_OFF + 128 * h + vc8);
    if (vt0 + 32 < ntok) vw1 = *(const GAS u32x4*)(Zg + (size_t)(vt0 + 32) * ZP + VB_OFF + 128 * h + vc8);
    if (MODE != 0) {
#pragma unroll
        for (int j = 0; j < 4; ++j) { const int idx = tid + 512 * j; sw[j] = *(const GAS f32x4*)(Sp_g + (idx >> 5) * 128 + (idx & 31) * 4); }
        if (pt < ntok) { const GAS bf16_t* rbp = Zg + (size_t)pt * ZP + RB_OFF + 128 * h + 16 * (tid & 7); rw0 = *(const GAS u32x4*)rbp; rw1 = *(const GAS u32x4*)(rbp + 8); }
    }
    LAS float* LA = (LAS float*)(lds + G_LA); LAS float* ALR = (LAS float*)(lds + G_ALR); LAS float* WG = (LAS float*)(lds + G_WG); LAS float* BG = (LAS float*)(lds + G_BG); LAS float* SEG = (LAS float*)(lds + G_SEG);
    LAS bf16_t* KE = (LAS bf16_t*)(lds + G_KE); LAS bf16_t* KDT = (LAS bf16_t*)(lds + G_KDT); LAS bf16_t* QE = (LAS bf16_t*)(lds + G_QE); LAS bf16_t* ATT = (LAS bf16_t*)(lds + G_ATT);
    LAS bf16_t* VT = (LAS bf16_t*)(lds + G_VT); LAS bf16_t* ST = (LAS bf16_t*)(lds + G_ST); LAS float* OB = (LAS float*)(lds + 0);
#pragma unroll
    for (int j = 0; j < 2; ++j) { const int e = tid + 512 * j, t = e >> 4, r = e & 15; ALR[e] = (t < ntok) ? bf2f(Zg[(size_t)t * ZP + ALR_OFF + r]) : 0.f;
        const int rr = e >> 6, d = e & 63; WG[e] = wgu_g[rr * 256 + 64 * h + d]; }
    if (tid < 64) BG[tid] = bg_g[64 * h + tid];
    __syncthreads();
#pragma unroll
    for (int j = 0; j < 8; ++j) { const int e = tid + 512 * j, t = e >> 6, d = e & 63; float x = BG[d];
#pragma unroll
        for (int r = 0; r < 16; ++r) x += ALR[t * 16 + r] * WG[r * 64 + d];
        const float ls = fminf(x, 0.f) - __logf(1.f + __expf(-fabsf(x)));
        LA[t * 65 + d] = (t < ntok) ? ls * (1.f / 16.f) : 0.f; }
    __syncthreads();
    { const int d = tid & 63, sg = tid >> 6; float run = 0.f;
#pragma unroll
      for (int i = 0; i < 8; ++i) { run += LA[(8 * sg + i) * 65 + d]; LA[(8 * sg + i) * 65 + d] = run; }
      SEG[sg * 64 + d] = run;
      __syncthreads();
      float pre = 0.f;
#pragma unroll
      for (int q = 0; q < 8; ++q) pre += (q < sg) ? SEG[q * 64 + d] : 0.f;
#pragma unroll
      for (int i = 0; i < 8; ++i) LA[(8 * sg + i) * 65 + d] += pre; }
    __syncthreads();
    { f32x4 q0, q1, k0, k1; pg8::unpack8(qw, q0, q1); pg8::unpack8(kw, k0, k1); f32x4 e0, e1, f0, f1;
#pragma unroll
      for (int i = 0; i < 8; ++i) { const int d = pd8 + i; const float b = LA[pt * 65 + d], bl = LA[63 * 65 + d]; const float q = (i < 4) ? q0[i & 3] : q1[i & 3], k = (i < 4) ? k0[i & 3] : k1[i & 3];
          const float qe = q * __expf(b), ke = k * __expf(-b); if (i < 4) { e0[i & 3] = qe; f0[i & 3] = ke; } else { e1[i & 3] = qe; f1[i & 3] = ke; }
          KDT[d * 72 + pt] = (bf16_t)f2bf(k * __expf(bl - b)); }
      *(LAS u32x4*)(QE + pt * 72 + pd8) = pg8::pack8(e0, e1); *(LAS u32x4*)(KE + pt * 72 + pd8) = pg8::pack8(f0, f1); }
#pragma unroll
    for (int i = 0; i < 4; ++i) { const unsigned a0 = vw0[i], a1 = vw1[i];
        VT[(vc8 + 2 * i) * 72 + vt0] = (bf16_t)(a0 & 0xffffu); VT[(vc8 + 2 * i + 1) * 72 + vt0] = (bf16_t)(a0 >> 16);
        VT[(vc8 + 2 * i) * 72 + vt0 + 32] = (bf16_t)(a1 & 0xffffu); VT[(vc8 + 2 * i + 1) * 72 + vt0 + 32] = (bf16_t)(a1 >> 16); }
    if (MODE != 0) {
#pragma unroll
        for (int j = 0; j < 4; ++j) { const int idx = tid + 512 * j, d = idx >> 5, c4 = (idx & 31) * 4;
#pragma unroll
            for (int i = 0; i < 4; ++i) ST[(c4 + i) * 72 + d] = (bf16_t)f2bf(sw[j][i]); }
    }
    if (MODE == 0 && tid < 64) dec_g[tid] = __expf(LA[63 * 65 + tid]);
    __syncthreads();
    if (MODE != 1) { const int mb = wid >> 2, nb = wid & 3; f32x16 acc;
#pragma unroll
        for (int r = 0; r < 16; ++r) acc[r] = 0.f;
#pragma unroll
        for (int ks = 0; ks < 4; ++ks) { const bf16x8 a = *(const LAS bf16x8*)(KDT + (32 * mb + r32) * 72 + 16 * ks + 8 * hi), b = *(const LAS bf16x8*)(VT + (32 * nb + r32) * 72 + 16 * ks + 8 * hi);
            acc = __builtin_amdgcn_mfma_f32_32x32x16_bf16(a, b, acc, 0, 0, 0); }
#pragma unroll
        for (int r = 0; r < 16; ++r) { const int d = 32 * mb + crow(r, hi), e = 32 * nb + r32;
            if (MODE == 0) ds_g[d * 128 + e] = acc[r];
            else sf_g[d * 128 + e] = __expf(LA[63 * 65 + d]) * Sp_g[d * 128 + e] + acc[r]; }
    }
    if (MODE != 0) {
        if (wid < 4) { const int ib = wid >> 1, jb = wid & 1; f32x16 acc;
#pragma unroll
            for (int r = 0; r < 16; ++r) acc[r] = 0.f;
#pragma unroll
            for (int ks = 0; ks < 4; ++ks) { const bf16x8 a = *(const LAS bf16x8*)(QE + (32 * ib + r32) * 72 + 16 * ks + 8 * hi), b = *(const LAS bf16x8*)(KE + (32 * jb + r32) * 72 + 16 * ks + 8 * hi);
                acc = __builtin_amdgcn_mfma_f32_32x32x16_bf16(a, b, acc, 0, 0, 0); }
#pragma unroll
            for (int r = 0; r < 16; ++r) { const int i = 32 * ib + crow(r, hi), jj = 32 * jb + r32; ATT[i * 72 + jj] = (bf16_t)f2bf(jj <= i ? acc[r] : 0.f); }
        }
        __syncthreads();
        { const int ib = wid >> 2, eb = wid & 3; f32x16 acc;
#pragma unroll
          for (int r = 0; r < 16; ++r) acc[r] = 0.f;
#pragma unroll
          for (int ks = 0; ks < 4; ++ks) { const bf16x8 a = *(const LAS bf16x8*)(ATT + (32 * ib + r32) * 72 + 16 * ks + 8 * hi), b = *(const LAS bf16x8*)(VT + (32 * eb + r32) * 72 + 16 * ks + 8 * hi);
              acc = __builtin_amdgcn_mfma_f32_32x32x16_bf16(a, b, acc, 0, 0, 0); }
#pragma unroll
          for (int ks = 0; ks < 4; ++ks) { const bf16x8 a = *(const LAS bf16x8*)(QE + (32 * ib + r32) * 72 + 16 * ks + 8 * hi), b = *(const LAS bf16x8*)(ST + (32 * eb + r32) * 72 + 16 * ks + 8 * hi);
              acc = __builtin_amdgcn_mfma_f32_32x32x16_bf16(a, b, acc, 0, 0, 0); }
#pragma unroll
          for (int r = 0; r < 16; ++r) OB[(32 * ib + crow(r, hi)) * 132 + 32 * eb + r32] = acc[r];
        }
        __syncthreads();
        { const int i = tid >> 3, sg = tid & 7; float v[16]; float ss = 0.f;
#pragma unroll
          for (int c = 0; c < 16; ++c) { v[c] = OB[i * 132 + 16 * sg + c]; ss += v[c] * v[c]; }
          ss += __shfl_xor(ss, 1); ss += __shfl_xor(ss, 2); ss += __shfl_xor(ss, 4);
          const float rstd = __builtin_amdgcn_rsqf(ss * (1.f / 128.f) + 1e-5f);
          if (i < ntok) {
#pragma unroll
              for (int hh = 0; hh < 2; ++hh) { const u32x4 rw = hh ? rw1 : rw0; f32x4 r0, r1; pg8::unpack8(rw, r0, r1); f32x4 o0, o1;
#pragma unroll
                  for (int c = 0; c < 4; ++c) { const float g0 = gl_g[16 * sg + 8 * hh + c], g1 = gl_g[16 * sg + 8 * hh + 4 + c];
                      o0[c] = v[8 * hh + c] * rstd * g0 * r0[c] * pg8::fast_sigmoid(r0[c]); o1[c] = v[8 * hh + 4 + c] * rstd * g1 * r1[c] * pg8::fast_sigmoid(r1[c]); }
                  *(GAS u32x4*)(Oout + (size_t)i * OP + 16 * sg + 8 * hh) = pg8::pack8(o0, o1); } }
        }
    }
    __syncthreads();
}

__device__ __forceinline__ unsigned char* opq(unsigned char* p) { asm volatile("" : "+s"(p)); return p; }
__device__ __forceinline__ float* opqf(float* p) { asm volatile("" : "+s"(p)); return p; }
#define XB_TMO      128
#define XB_XCNT(j)  (256  + 64 * (j))
#define XB_XSUB(j)  (1280 + 64 * (j))
#define XB_XGEN(j)  (2304 + 64 * (j))
#define XB_TOP      3328
#define XB_TOPGEN   3392
#define XCD_BAR_WORDS 3456
#define XB_SPIN_CAP (1u << 18)

__device__ __forceinline__ unsigned xb_ld(unsigned* p)              { return __hip_atomic_load(p, __ATOMIC_RELAXED, __HIP_MEMORY_SCOPE_AGENT); }
__device__ __forceinline__ unsigned xb_add(unsigned* p, unsigned v) { return __hip_atomic_fetch_add(p, v, __ATOMIC_RELAXED, __HIP_MEMORY_SCOPE_AGENT); }
__device__ __forceinline__ unsigned xb_xcc_id() { return (unsigned)__builtin_amdgcn_s_getreg((3 << 11) | 20) & 0xFu; }
#define XB_SPIN(cond, bar) do { unsigned _sp = 0; while (cond) { __builtin_amdgcn_s_sleep(1); \
    if ((++_sp & 255u) == 0u) { if (xb_ld(&(bar)[XB_TMO])) break; if (_sp > XB_SPIN_CAP) { atomicAdd(&(bar)[XB_TMO], 1u); break; } } } } while (0)

struct XcdBarrier {
    unsigned* bar; unsigned x;
    volatile LAS unsigned* st;
};

__device__ __forceinline__ XcdBarrier xcd_barrier_post(unsigned* bar, volatile LAS unsigned* st) {
    XcdBarrier b; b.bar = bar; b.x = xb_xcc_id(); b.st = st;
    if (threadIdx.x == 0) (void)xb_add(&bar[XB_XCNT(b.x)], 1u);
    return b;
}
__device__ __forceinline__ void xcd_barrier_complete(unsigned* bar, unsigned x, unsigned& nloc, unsigned& nx) {
    const unsigned G = gridDim.x * gridDim.y * gridDim.z;
    unsigned sum, cnt, mine, sp = 0u;
    for (;;) {
        sum = 0u; cnt = 0u; mine = 0u;
#pragma unroll
        for (unsigned j = 0; j < 16; ++j) { const unsigned c = xb_ld(&bar[XB_XCNT(j)]); sum += c; cnt += (c > 0u) ? 1u : 0u; mine = (j == x) ? c : mine; }
        if (sum == G) break;
        __builtin_amdgcn_s_sleep(1);
        if ((++sp & 255u) == 0u) { if (xb_ld(&bar[XB_TMO])) break; if (sp > XB_SPIN_CAP) { atomicAdd(&bar[XB_TMO], 1u); break; } }
    }
    nloc = mine > 0u ? mine : 1u; nx = cnt > 0u ? cnt : 1u;
}

__device__ __forceinline__ void xcd_barrier(const XcdBarrier& b) {
    asm volatile("s_waitcnt vmcnt(0)" ::: "memory");
    __syncthreads();
    if (threadIdx.x == 0) {
        unsigned* bar = b.bar;
        __builtin_amdgcn_s_waitcnt(0);
        unsigned nloc = b.st[0], nx = b.st[1];
        if (nloc == 0u) { xcd_barrier_complete(bar, b.x, nloc, nx); b.st[0] = nloc; b.st[1] = nx; }
        const unsigned old = xb_add(&bar[XB_XSUB(b.x)], 1u);
        const unsigned gen = old / nloc;
        if (old + 1u == (gen + 1u) * nloc) {
            __builtin_amdgcn_fence(__ATOMIC_RELEASE, "agent");
            asm volatile("s_waitcnt vmcnt(0)" ::: "memory");
            const unsigned og = xb_add(&bar[XB_TOP], 1u);
            const unsigned tg = og / nx;
            if (og + 1u == (tg + 1u) * nx) xb_add(&bar[XB_TOPGEN], 1u);
            else XB_SPIN(xb_ld(&bar[XB_TOPGEN]) == tg, bar);
            __builtin_amdgcn_fence(__ATOMIC_ACQUIRE, "agent");
            xb_add(&bar[XB_XGEN(b.x)], 1u);
            asm volatile("s_waitcnt vmcnt(0)" ::: "memory");
        } else {
            XB_SPIN(xb_ld(&bar[XB_XGEN(b.x)]) == gen, bar);
            __builtin_amdgcn_fence(__ATOMIC_ACQUIRE, "agent");
            asm volatile("s_waitcnt vmcnt(0)" ::: "memory");
        }
    }
    __syncthreads();
}

template <class Epi> __device__ __forceinline__ void run_gemm(LAS unsigned char* lds, const bf16_t* A, const bf16_t* Bt, int M, int N, int K, const Epi& E) {
    pg8::Gemm g{A, Bt, M, N, K}; pg8::StaticOrder S; S.init(M, N, (int)gridDim.x, (int)blockIdx.x);
    pg8::gemm_phase<Epi, pg8::StaticOrder, true, true>(lds, g, S, E);
}

constexpr float QSCALE = 0.125f * 1.4426950408889634f;

__global__ void __launch_bounds__(512, 2) mega_fwd(Params P) {
    extern __shared__ __attribute__((aligned(16))) unsigned char lds_raw[];
    LAS unsigned char* lds = (LAS unsigned char*)lds_raw;
    cg::grid_group grid = cg::this_grid();
    int tid = threadIdx.x; asm volatile("" : "+v"(tid)); int lane = tid & 63, wid = __builtin_amdgcn_readfirstlane(tid >> 6);
    const int G = gridDim.x, bid = blockIdx.x, NGW = G * 8; int gw = bid * 8 + wid;
    unsigned char* wsl = opq(P.ws); float* outl = opqf(P.out);
#define NEWPHASE() do { wsl = opq(P.ws); outl = opqf(P.out); tid = threadIdx.x; asm volatile("" : "+v"(tid)); lane = tid & 63; wid = __builtin_amdgcn_readfirstlane(tid >> 6); gw = bid * 8 + wid; } while (0)
#define WSB() wsl
#define GSYNC() do { XcdBarrier b_; b_.bar = (unsigned*)(opq(P.ws) + W_CTR) + 1024; b_.x = xb_xcc_id(); b_.st = (volatile LAS unsigned*)(misc + 8); xcd_barrier(b_); NEWPHASE(); } while (0)
#define PB(off) ((bf16_t*)(WSB() + (off)))
#define PF(off) ((float*)(WSB() + (off)))
#define ctr ((unsigned*)(WSB() + W_CTR))
#define WGU PB(W_WGU)
#define WD PB(W_WD)
#define WIN PB(W_WIN)
#define WOA PB(W_WOA)
#define WOB PB(W_WOB)
#define WO PB(W_WO)
#define H PB(W_H)
#define ACT PB(W_ACT)
#define Y PB(W_Y)
#define Z PB(W_Z)
#define OA PB(W_OAB)
#define OB (PB(W_OAB) + (size_t)MALL * OP)
#define MIX PB(W_MIX)
#define KC PB(W_KC)
#define VC PB(W_VC)
#define DS PF(W_DS)
#define DEC PF(W_DEC)
#define ropec PF(W_ROPE)
#define ropes (PF(W_ROPE) + (size_t)MP * 32)
#define xbuf outl
    LAS unsigned* misc = (LAS unsigned*)(lds + LDS_MAIN);
    if (threadIdx.x < 4) misc[8 + threadIdx.x] = 0u;
    __syncthreads();
    (void)xcd_barrier_post((unsigned*)(P.ws + W_CTR) + 1024, (volatile LAS unsigned*)(misc + 8));
    grid.sync();

    { LAS float* finv = (LAS float*)(lds + LDS_MAIN + 256);
#pragma unroll
      for (int d = 0; d < 32; ++d) if (tid == d) finv[d] = P.inv_freq[d];
      __syncthreads();
      for (int idx = bid * 512 + tid; idx < MP * 32; idx += G * 512) { const int pos = idx >> 5, d = idx & 31; const float ang = (float)pos * finv[d];
          double rev = (double)ang * 0.15915494309189535; rev -= floor(rev); const float fr = (float)rev;
          ropec[idx] = __builtin_amdgcn_cosf(fr); ropes[idx] = __builtin_amdgcn_sinf(fr); }
      __syncthreads();
    }
    { LAS float* scr = (LAS float*)(lds + wid * 8448);
      for (int it = gw; it < 24320; it += NGW) { int r = it;
          if (r < 16896) { const int lf = r / 4224; r -= lf * 4224;
              if (r < 2816) transpose_item(P.w_gate + (size_t)lf * DM * DFF, P.w_up + (size_t)lf * DM * DFF, DFF, DM, 1, WGU + (size_t)lf * NGU * DM, scr, r, 176, lane);
              else transpose_item(P.w_down + (size_t)lf * DFF * DM, nullptr, DM, DFF, 0, WD + (size_t)lf * DM * DFF, scr, r - 2816, 32, lane);
          } else { r -= 16896; const int l = r / 3712; r -= l * 3712;
              if (r < 2688) transpose_item(P.w_in + (size_t)l * DM * 5136, nullptr, 5136, DM, 2, WIN + (size_t)l * ZP * DM, scr, r, 168, lane);
              else if (r < 2944) transpose_item(P.w_out_a + (size_t)l * 512 * DM, nullptr, DM, 512, 0, WOA + (size_t)l * DM * 512, scr, r - 2688, 32, lane);
              else if (r < 3200) transpose_item(P.w_out_b + (size_t)l * 512 * DM, nullptr, DM, 512, 0, WOB + (size_t)l * DM * 512, scr, r - 2944, 32, lane);
              else transpose_item(P.w_out + (size_t)l * DM * DM, nullptr, DM, DM, 0, WO + (size_t)l * DM * DM, scr, r - 3200, 32, lane); } }
    }
    rownorm_phase(P.x_prompt, P.x_sample, xbuf, nullptr, nullptr, 0.f, P.norm_g, H, gw, NGW, lane);
    GSYNC();

#pragma unroll
    for (int l = 0; l < 2; ++l) {
        const float* ng = P.norm_g + (size_t)l * 6 * DM;
        run_gemm(lds, H, WGU + (size_t)(l * 2) * NGU * DM, MALL, NGU, DM, pg8::EpiSwiGLU{ACT, DFF});
        GSYNC();
        run_gemm(lds, ACT, WD + (size_t)(l * 2) * DM * DFF, MP, DM, DFF, pg8::EpiPlain{Y, DM});
        gemm_small<0>(lds, ACT + (size_t)MP * DFF, WD + (size_t)(l * 2) * DM * DFF, DFF, nullptr, nullptr, 0, Y + (size_t)MP * DM, DM, nullptr);
        GSYNC();
        rownorm_phase(xbuf, xbuf + (size_t)MP * DM, xbuf, Y, ng + 1 * DM, 0.5f, ng + 2 * DM, H, gw, NGW, lane);
        GSYNC();
        {

                { pg8::EpiInProj E{Z, ZP, ropec, ropes, P.out + O_KP + (size_t)l * MP * 512, P.out + O_VP + (size_t)l * MP * 512, P.out + O_KS + (size_t)l * MS * 512, P.out + O_VS + (size_t)l * MS * 512,
                                   KC + (size_t)l * 32 * KCROWS * 512, VC + (size_t)l * 32 * KCROWS * 512, QSCALE};
                  run_gemm(lds, H, WIN + (size_t)l * ZP * DM, MALL, ZP, DM, E); }
                GSYNC();
#if defined(STOP_AT) && STOP_AT == 2
                return;
#endif
                const float* wgu = P.w_gate_up + (size_t)l * 16 * 256; const float* bgp = P.b_gate + (size_t)l * 256;
                for (int u = bid; u < NCHUNK * 4; u += G) { const int n = u >> 2, h = u & 3;
                    gla_unit<0>(lds, Z + (size_t)(64 * n) * ZP, 64, wgu, bgp, h, DS + (size_t)u * 8192, DEC + (size_t)u * 64, nullptr, nullptr, nullptr, nullptr); }
                GSYNC();
                { LAS float* SA = (LAS float*)lds; LAS float* SBv = SA + 512; const int el = tid & 127, sg = tid >> 7;
                  for (int base = bid * 128; base < 32768; base += G * 128) { const int gid = base + el, hd = gid >> 7, e = gid & 127;
                    GAS float* dsp = (GAS float*)(DS + (size_t)hd * 128 + e + (size_t)(64 * sg) * 32768); const GAS float* dcp = (const GAS float*)(DEC + hd + (64 * sg) * 256);
                    float A = 1.f, B = 0.f;
                    for (int n = 0; n < 64; n += 16) { float v[16], c[16];
#pragma unroll
                        for (int j = 0; j < 16; ++j) { v[j] = dsp[(size_t)(n + j) * 32768]; c[j] = dcp[(n + j) * 256]; }
#pragma unroll
                        for (int j = 0; j < 16; ++j) { B = c[j] * B + v[j]; A *= c[j]; } }
                    SA[sg * 128 + el] = A; SBv[sg * 128 + el] = B;
                    __syncthreads();
                    float S = 0.f;
#pragma unroll
                    for (int q = 0; q < 3; ++q) if (q < sg) S = SA[q * 128 + el] * S + SBv[q * 128 + el];
                    for (int n = 0; n < 64; n += 16) { float v[16], c[16];
#pragma unroll
                        for (int j = 0; j < 16; ++j) { v[j] = dsp[(size_t)(n + j) * 32768]; c[j] = dcp[(n + j) * 256]; }
#pragma unroll
                        for (int j = 0; j < 16; ++j) { const float prev = S; S = c[j] * S + v[j]; dsp[(size_t)(n + j) * 32768] = prev; } }
                    if (sg == 3) P.out[O_SP + (size_t)l * 32768 + gid] = S;
                    __syncthreads(); } }
                GSYNC();
                { int lq = l; asm volatile("" : "+s"(lq)); const float lam_init = (lq == 0) ? 0.2f : 0.35550906f; const float* lf = P.lambda_p + (size_t)l * 256;
                  const float lam_v = __expf(wave_sum(lf[lane] * lf[64 + lane])) - __expf(wave_sum(lf[128 + lane] * lf[192 + lane])) + lam_init;
                  const float lam = __uint_as_float(__builtin_amdgcn_readfirstlane(__float_as_uint(lam_v)));
                  const float osc = __uint_as_float(__builtin_amdgcn_readfirstlane(__float_as_uint(1.f - lam_init)));
                  const float* subg = P.subln_g + (size_t)l * 128; const float* glang = P.gla_norm_g + (size_t)l * 128;
                  const bf16_t* KCl = KC + (size_t)l * 32 * KCROWS * 512; const bf16_t* VCl = VC + (size_t)l * 32 * KCROWS * 512;
                  const unsigned hq0 = xb_xcc_id() & 3u; unsigned exh = 0u;
                  for (;;) {
                      if (tid == 0) { unsigned code = 0xffffffffu;
                          for (unsigned kq = 0; kq < 4u && code == 0xffffffffu; ++kq) { const unsigned hh = (hq0 + kq) & 3u;
                              if (!((exh >> hh) & 1u)) { const unsigned idx = atomicAdd(&ctr[l * 16 + hh], 1u); if (idx < 160u) code = (idx < 112u) ? ((127u - idx) * 4u + hh) : (idx < 144u) ? (512u + (idx - 112u) * 4u + hh) : ((15u - (idx - 144u)) * 4u + hh); else exh |= 1u << hh; } }
                          if (code == 0xffffffffu) { const unsigned idx = atomicAdd(&ctr[l * 16 + 4], 1u); if (idx < 1152u) code = 640u + idx; }
                          misc[0] = code; }
                      __syncthreads();
                      const unsigned u = misc[0];
                      __syncthreads();
                      if (u == 0xffffffffu) break;
                      if (u < 640u) {
#ifndef SKIP_ATTN
                          int smp = 0, qb = 0, h = (int)(u & 3), b = 0;
                          if (u < 512u) qb = (int)(u >> 2); else { smp = 1; b = (int)((u - 512u) >> 2); }
                          if (!smp) { const int q0 = 128 * qb;
                              attn_unit(lds, Z + (size_t)q0 * ZP + QA_OFF + 128 * h, ZP, 127, Z + KA_OFF + 128 * h, Z + VA_OFF + 128 * h, ZP, nullptr, nullptr, 2 * qb + 2, 64, 0, q0, OA + (size_t)q0 * OP + 128 * h, 128, lam, subg, osc);
                          } else { const int R0 = MP + 16 * b;
                              attn_unit(lds, Z + (size_t)R0 * ZP + QA_OFF + 128 * h, ZP, 15, KCl + (size_t)b * KCROWS * 512 + 128 * h, VCl + (size_t)b * KCROWS * 512 + 128 * h, 512, P.cache_k + ((size_t)(l * 32 + b) * PAST) * 512 + 128 * h, P.cache_v + ((size_t)(l * 32 + b) * PAST) * 512 + 128 * h, 33, 16, 1, 0, OA + (size_t)R0 * OP + 128 * h, 16, lam, subg, osc); }
#endif
                      } else if (u < 1664u) { const int v = (int)u - 640, n = v >> 2, h = v & 3;
#ifndef SKIP_GLA12
                          gla_unit<1>(lds, Z + (size_t)(64 * n) * ZP, 64, wgu, bgp, h, nullptr, nullptr, DS + (size_t)v * 8192, nullptr, glang, OB + (size_t)(64 * n) * OP + 128 * h);
#endif
                      } else { const int v = (int)u - 1664, b = v >> 2, h = v & 3; const int R0 = MP + 16 * b;
#ifndef SKIP_GLA12
                          gla_unit<2>(lds, Z + (size_t)R0 * ZP, 16, wgu, bgp, h, nullptr, nullptr, P.state_gla + ((size_t)(l * 32 + b) * 4 + h) * 8192, P.out + O_SS + ((size_t)(l * 32 + b) * 4 + h) * 8192, glang, OB + (size_t)R0 * OP + 128 * h);
#endif
 }
                  } }
                GSYNC();
                run_gemm(lds, OA, WOA + (size_t)l * DM * 512, MP, DM, 512, pg8::EpiGate<false>{MIX, nullptr, DM, Z + GA_OFF, ZP});
                run_gemm(lds, OB, WOB + (size_t)l * DM * 512, MP, DM, 512, pg8::EpiGate<true>{MIX, MIX, DM, Z + GB_OFF, ZP});
                gemm_small<1>(lds, OA + (size_t)MP * OP, WOA + (size_t)l * DM * 512, 512, OB + (size_t)MP * OP, WOB + (size_t)l * DM * 512, 512, MIX + (size_t)MP * DM, DM, Z + (size_t)MP * ZP);
                GSYNC();
                run_gemm(lds, MIX, WO + (size_t)l * DM * DM, MP, DM, DM, pg8::EpiPlain{Y, DM});
                gemm_small<0>(lds, MIX + (size_t)MP * DM, WO + (size_t)l * DM * DM, DM, nullptr, nullptr, 0, Y + (size_t)MP * DM, DM, nullptr);
                GSYNC();
                rownorm_phase(xbuf, xbuf + (size_t)MP * DM, xbuf, Y, ng + 3 * DM, 1.0f, ng + 4 * DM, H, gw, NGW, lane);
                GSYNC();
#if defined(STOP_AT) && STOP_AT == 4
                return;
#endif

        }
        run_gemm(lds, H, WGU + (size_t)(l * 2 + 1) * NGU * DM, MALL, NGU, DM, pg8::EpiSwiGLU{ACT, DFF});
        GSYNC();
        run_gemm(lds, ACT, WD + (size_t)(l * 2 + 1) * DM * DFF, MP, DM, DFF, pg8::EpiPlain{Y, DM});
        gemm_small<0>(lds, ACT + (size_t)MP * DFF, WD + (size_t)(l * 2 + 1) * DM * DFF, DFF, nullptr, nullptr, 0, Y + (size_t)MP * DM, DM, nullptr);
        GSYNC();
        if (l == 0) { rownorm_phase(xbuf, xbuf + (size_t)MP * DM, xbuf, Y, ng + 5 * DM, 0.5f, P.norm_g + 6 * DM, H, gw, NGW, lane); GSYNC(); }
        else rownorm_phase(xbuf, xbuf + (size_t)MP * DM, xbuf, Y, ng + 5 * DM, 0.5f, nullptr, nullptr, gw, NGW, lane);
    }
}

#undef WSB
#undef NEWPHASE
#undef GSYNC
#undef PB
#undef PF
#undef ctr
#undef WGU
#undef WD
#undef WIN
#undef WOA
#undef WOB
#undef WO
#undef H
#undef ACT
#undef Y
#undef Z
#undef OA
#undef OB
#undef MIX
#undef KC
#undef VC
#undef DS
#undef DEC
#undef ropec
#undef ropes
#undef xbuf
extern "C" void kernel_launch(void* const* d_in, const int* in_sizes, int n_in, void* d_out, int out_size, void* d_ws, size_t ws_size, hipStream_t stream) {
    static int grid_blocks = 0;
    if (grid_blocks == 0) {
        if (n_in != 18 || (size_t)out_size != O_END || ws_size < W_END) { fprintf(stderr, "kernel_launch: unexpected sizes n_in %d out %d ws %zu (need %zu)\n", n_in, out_size, ws_size, (size_t)W_END); grid_blocks = -1; return; }
        int dev = 0, cus = 0, per_cu = 0;
        hipGetDevice(&dev); hipDeviceGetAttribute(&cus, hipDeviceAttributeMultiprocessorCount, dev);
        if (hipFuncSetAttribute((const void*)mega_fwd, hipFuncAttributeMaxDynamicSharedMemorySize, LDS_TOTAL) != hipSuccess) { fprintf(stderr, "kernel_launch: hipFuncSetAttribute failed\n"); grid_blocks = -1; return; }
        if (hipOccupancyMaxActiveBlocksPerMultiprocessor(&per_cu, (const void*)mega_fwd, 512, LDS_TOTAL) != hipSuccess || per_cu < 1) { fprintf(stderr, "kernel_launch: occupancy query gave %d\n", per_cu); per_cu = 1; }
        (void)hipGetLastError();
        grid_blocks = cus * 1;
    }
    if (grid_blocks < 0) return;
    Params p{};
    const float** pp = (const float**)&p;
    for (int i = 0; i < 18; ++i) pp[i] = (const float*)d_in[i];
    p.out = (float*)d_out; p.ws = (unsigned char*)d_ws;
    for (int d = 0; d < 32; ++d) p.inv_freq[d] = (float)exp(-log(10000.0) * (double)d / 32.0);
    if (hipMemsetAsync((char*)d_ws + W_CTR, 0, 65536, stream) != hipSuccess) { fprintf(stderr, "kernel_launch: memset failed\n"); return; }
    void* args[] = {&p};
    hipError_t e = hipLaunchCooperativeKernel((const void*)mega_fwd, dim3(grid_blocks), dim3(512), args, LDS_TOTAL, stream);
    if (e != hipSuccess) fprintf(stderr, "cooperative launch failed: %s (grid %d)\n", hipGetErrorString(e), grid_blocks);
}
```
